# Optimizing an MI355X kernel written in HIP

```python
import math
import jax, jax.numpy as jnp
from jax import lax
import numpy as np

D_MODEL = 2048
BATCH = 2
SEQ = 4096
DEPTH = 2

GLA_HEADS = 4
GLA_HEAD_K = D_MODEL // (2 * GLA_HEADS)
GLA_HEAD_V = D_MODEL // GLA_HEADS
GLA_GATE_RANK = 16
GLA_GATE_NORMALIZER = 16.0
GLA_CHUNK = 64
GLA_QK_W = GLA_HEADS * GLA_HEAD_K
GLA_V_W = GLA_HEADS * GLA_HEAD_V

DSA_HEADS = 16
DSA_HEAD_DIM = D_MODEL // DSA_HEADS
DSA_LATENT = 256
DSA_TOPK = 256
DSA_Q_BLOCK = 128
IDX_HEADS = 16
IDX_DIM = 64
DSA_Q_W = DSA_HEADS * DSA_LATENT

REL_BUCKETS = 32
REL_MAX_DIST = 128

D_FF = 4 * D_MODEL
N_MOD = 6
EPS = 1e-6

IN_SIZES = (GLA_QK_W, GLA_QK_W, GLA_V_W, GLA_GATE_RANK, GLA_V_W,
            DSA_Q_W, DSA_LATENT, IDX_HEADS * IDX_DIM, IDX_DIM, IDX_HEADS,
            D_MODEL, D_MODEL)
N_IN = sum(IN_SIZES)

kernel_name = "hybrid_gla_dsa_gated_parallel"


def rms_norm(x, g):
    xf = x.astype(jnp.float32)
    y = xf * lax.rsqrt(jnp.mean(xf * xf, axis=-1, keepdims=True) + EPS)
    return (y * g.astype(jnp.float32)).astype(x.dtype)


def split_cols(z):
    parts, off = [], 0
    for s in IN_SIZES:
        parts.append(z[..., off:off + s])
        off += s
    return parts


def rel_bucket(dist):
    max_exact = REL_BUCKETS // 2
    d = jnp.maximum(dist, 0)
    df = jnp.maximum(d, 1).astype(jnp.float32)
    large = max_exact + (jnp.log(df / max_exact) / math.log(REL_MAX_DIST / max_exact)
                         * (REL_BUCKETS - max_exact)).astype(jnp.int32)
    large = jnp.minimum(large, REL_BUCKETS - 1)
    return jnp.where(d < max_exact, d, large)


def gla_branch(q, k, v, a_low, r, w_a2, b_a, g_norm):
    B, S, _ = q.shape
    H, dk, dv, C = GLA_HEADS, GLA_HEAD_K, GLA_HEAD_V, GLA_CHUNK
    n = S // C
    f32 = jnp.float32
    qf = q.reshape(B, S, H, dk).astype(f32) * (dk ** -0.5)
    kf = k.reshape(B, S, H, dk).astype(f32)
    vf = v.reshape(B, S, H, dv).astype(f32)
    g = jax.nn.log_sigmoid((a_low @ w_a2 + b_a).astype(f32)) / GLA_GATE_NORMALIZER
    g = g.reshape(B, S, H, dk)

    def to_chunks(t):
        return t.reshape(B, n, C, H, t.shape[-1]).transpose(1, 0, 3, 2, 4)

    tril = jnp.tril(jnp.ones((C, C), dtype=bool))

    def step(state, inp):
        qc, kc, vc, gc = inp
        b = jnp.cumsum(gc, axis=2)
        o_inter = jnp.einsum('bhcd,bhde->bhce', qc * jnp.exp(b), state)
        diff = b[:, :, :, None, :] - b[:, :, None, :, :]
        decay = jnp.exp(jnp.where(tril[:, :, None], diff, -jnp.inf))
        attn = jnp.sum(qc[:, :, :, None, :] * kc[:, :, None, :, :] * decay, axis=-1)
        o = o_inter + jnp.einsum('bhij,bhje->bhie', attn, vc)
        b_last = b[:, :, -1:, :]
        state = (jnp.exp(b_last[:, :, 0, :])[..., None] * state
                 + jnp.einsum('bhcd,bhce->bhde', kc * jnp.exp(b_last - b), vc))
        return state, o

    state0 = jnp.zeros((B, H, dk, dv), f32)
    _, o = lax.scan(step, state0, (to_chunks(qf), to_chunks(kf), to_chunks(vf), to_chunks(g)))
    o = o.transpose(1, 0, 3, 2, 4).reshape(B, S, H, dv)
    o = o * lax.rsqrt(jnp.mean(o * o, axis=-1, keepdims=True) + EPS) * g_norm.astype(f32)
    o = o.reshape(B, S, GLA_V_W) * jax.nn.silu(r.astype(f32))
    return o.astype(q.dtype)


def dsa_branch(q_lat, kv_lat, iq, ik, iw, kv_g, w_uv, rel_bias):
    B, S, _ = q_lat.shape
    k_sel = min(DSA_TOPK, S // 4)
    nb = S // DSA_Q_BLOCK
    f32 = jnp.float32
    kv = rms_norm(kv_lat, kv_g)
    q4 = q_lat.reshape(B, S, DSA_HEADS, DSA_LATENT)
    iq4 = iq.reshape(B, S, IDX_HEADS, IDX_DIM)
    kpos = jnp.arange(S, dtype=jnp.int32)

    def blocks(t):
        return t.reshape(B, nb, DSA_Q_BLOCK, *t.shape[2:]).swapaxes(0, 1)

    def one_block(inp):
        qb, iqb, iwb, start = inp
        qpos = start + jnp.arange(DSA_Q_BLOCK, dtype=jnp.int32)
        idx_logits = jax.nn.relu(jnp.einsum('bqhd,bkd->bqhk', iqb, ik).astype(f32) * (IDX_DIM ** -0.5))
        score = jnp.einsum('bqh,bqhk->bqk', iwb.astype(f32) * (IDX_HEADS ** -0.5), idx_logits)
        score = jnp.where(kpos[None, None, :] <= qpos[None, :, None], score, -jnp.inf)
        _, idx = lax.top_k(score, k_sel)
        sel = jax.vmap(lambda kvb, ib: kvb[ib])(kv, idx)
        rel = qpos[None, :, None] - idx
        bias = jnp.moveaxis(rel_bias[rel_bucket(rel)], -1, 2)
        logits = (jnp.einsum('bqhl,bqkl->bqhk', qb, sel).astype(f32) * (DSA_LATENT ** -0.5)
                  + bias.astype(f32))
        valid = (rel >= 0)[:, :, None, :]
        probs = jax.nn.softmax(jnp.where(valid, logits, -jnp.inf), axis=-1).astype(sel.dtype)
        o_lat = jnp.einsum('bqhk,bqkl->bqhl', probs, sel)
        o = jnp.einsum('bqhl,hld->bqhd', o_lat, w_uv)
        return o.reshape(B, DSA_Q_BLOCK, DSA_HEADS * DSA_HEAD_DIM)

    starts = jnp.arange(nb, dtype=jnp.int32) * DSA_Q_BLOCK
    out = lax.map(one_block, (blocks(q4), blocks(iq4), blocks(iw), starts))
    return out.swapaxes(0, 1).reshape(B, S, DSA_HEADS * DSA_HEAD_DIM)


def setup_inputs(seed: int = 0) -> dict:
    key = jax.random.key(seed)
    ks = jax.random.split(key, 17)
    f32 = jnp.float32
    D = D_MODEL
    nrm = lambda k, shape, s: jax.random.normal(k, shape, f32) * s
    return {
        "x": nrm(ks[0], (BATCH, SEQ, D), 1.0),
        "c": nrm(ks[1], (BATCH, D), 1.0),
        "w_mod": nrm(ks[2], (DEPTH, D, N_MOD * D), 0.5 * D ** -0.5),
        "b_mod": nrm(ks[3], (DEPTH, N_MOD * D), 0.02),
        "norm1_g": 1.0 + nrm(ks[4], (DEPTH, D), 0.02),
        "w_in": nrm(ks[5], (DEPTH, D, N_IN), D ** -0.5),
        "w_gate_up": nrm(ks[6], (DEPTH, GLA_GATE_RANK, GLA_QK_W), GLA_GATE_RANK ** -0.5),
        "b_gate": nrm(ks[7], (DEPTH, GLA_QK_W), 0.1),
        "gla_norm_g": 1.0 + nrm(ks[8], (DEPTH, GLA_HEAD_V), 0.02),
        "kv_norm_g": 1.0 + nrm(ks[9], (DEPTH, DSA_LATENT), 0.02),
        "w_uv": nrm(ks[10], (DEPTH, DSA_HEADS, DSA_LATENT, DSA_HEAD_DIM), DSA_LATENT ** -0.5),
        "w_out": nrm(ks[11], (DEPTH, D, D), D ** -0.5),
        "norm2_g": 1.0 + nrm(ks[12], (DEPTH, D), 0.02),
        "w_ff1": nrm(ks[13], (DEPTH, D, D_FF), D ** -0.5),
        "w_ff2": nrm(ks[14], (DEPTH, D_FF, D), D_FF ** -0.5),
        "rel_bias": nrm(ks[15], (REL_BUCKETS, DSA_HEADS), 0.5),
        "final_g": 1.0 + nrm(ks[16], (D,), 0.02),
    }


def reference(x, c, w_mod, b_mod, norm1_g, w_in, w_gate_up, b_gate, gla_norm_g, kv_norm_g,
              w_uv, w_out, norm2_g, w_ff1, w_ff2, rel_bias, final_g):
    c_act = jax.nn.silu(c)
    for l in range(DEPTH):
        mod = c_act @ w_mod[l] + b_mod[l]
        sh1, sc1, gt1, sh2, sc2, gt2 = [m[:, None, :] for m in jnp.split(mod, N_MOD, axis=-1)]

        h = rms_norm(x, norm1_g[l]) * (1.0 + sc1) + sh1
        (q_g, k_g, v_g, a_low, r_g, q_lat, kv_lat, iq, ik, iw,
         g_gla, g_dsa) = split_cols(h @ w_in[l])
        y_gla = gla_branch(q_g, k_g, v_g, a_low, r_g, w_gate_up[l], b_gate[l], gla_norm_g[l])
        y_dsa = dsa_branch(q_lat, kv_lat, iq, ik, iw, kv_norm_g[l], w_uv[l], rel_bias)
        merged = jax.nn.sigmoid(g_gla) * y_gla + jax.nn.sigmoid(g_dsa) * y_dsa
        x = x + gt1 * (merged @ w_out[l])

        h = rms_norm(x, norm2_g[l]) * (1.0 + sc2) + sh2
        u = jnp.square(jax.nn.relu(h @ w_ff1[l]))
        x = x + gt2 * (u @ w_ff2[l])
    return rms_norm(x, final_g)
```

```cpp
#include <hip/hip_runtime.h>
#include <hip/hip_cooperative_groups.h>
#include <cstdio>
#include <cstdint>
namespace cg = cooperative_groups;
#ifndef MK_SINGLE
#define MK_SINGLE 1
#endif
__device__ __forceinline__ int TIDX() { int t = threadIdx.x; asm volatile("" : "+v"(t)); return t; }
__device__ __forceinline__ int BIDX() { int t = blockIdx.x; asm volatile("" : "+s"(t)); return t; }
namespace pg8 {
#define PG8_LAS __attribute__((address_space(3)))
typedef unsigned short bf16_t;
typedef short bf16x8 __attribute__((ext_vector_type(8)));
typedef float f32x4 __attribute__((ext_vector_type(4)));
typedef unsigned u32x4 __attribute__((ext_vector_type(4)));
constexpr int BM = 256, BK = 64, HALF = 128, HTB = HALF * BK * 2  , STAGE_BYTES = 8 * HTB, NXCD = 8, WGM = 8;

__host__ __device__ __forceinline__ int lds_byte(int r, int c) { const int st = (r >> 4) * 2 + (c >> 5), rr = r & 15, cc = c & 31, ob = rr * 64 + cc * 2; return st * 1024 + (ob ^ (((ob >> 9) & 1) << 5)); }
__host__ __device__ __forceinline__ void stage_rc(int b, int& R, int& C) { const int st = b / 1024, sb = b % 1024, swz = sb ^ (((sb >> 9) & 1) << 5); R = (st >> 1) * 16 + swz / 64; C = (st & 1) * 32 + (swz % 64) / 2; }
__host__ __device__ __forceinline__ int perm32(int rho) { const int n = rho >> 4, i = rho & 15; return 8 * (i >> 2) + 4 * n + (i & 3); }

struct Unit { int pm, pn; };
struct Gemm { const bf16_t* A; const bf16_t* Bt; int M, N, K; };

struct StaticOrder {
    int nM, nN, nwg, G, c;
    __host__ __device__ void init(int M, int N, int G_, int c_) { nM = M / BM; nN = N / BM; nwg = nM * nN; G = G_; c = c_; }
    __host__ __device__ bool next(int i, Unit& u) const {
        const long L = (long)i * G + c; if (L >= nwg) return false;
        int wgid = (int)L; { const int q = nwg / NXCD, r = nwg % NXCD, xcd = wgid % NXCD, off = wgid / NXCD; wgid = (xcd < r ? xcd * (q + 1) : r * (q + 1) + (xcd - r) * q) + off; }
        const int nig = WGM * nN, gid = wgid / nig, fm = gid * WGM, gsz = (nM - fm) < WGM ? (nM - fm) : WGM;
        u.pm = fm + ((wgid % nig) % gsz); u.pn = (wgid % nig) / gsz; return true;
    }
    __device__ __forceinline__ void a_ready(const Unit&) const {}
    __device__ __forceinline__ void done(const Unit&) const {}
};

__device__ __forceinline__ unsigned cvt_pk_bf16(float lo, float hi) { unsigned r; asm volatile("v_cvt_pk_bf16_f32 %0, %1, %2" : "=v"(r) : "v"(lo), "v"(hi)); return r; }
template <class Epi, class Sched, bool ALIGN_EPI = false, bool SP2 = false>
__device__ __forceinline__ void gemm_phase(PG8_LAS unsigned char* lds, const Gemm g, const Sched& S, const Epi& E) {
    const int tid = TIDX(), wid = __builtin_amdgcn_readfirstlane(tid >> 6), lane = tid & 63, wr = wid >> 2, wc = wid & 3, fr = lane & 15, fq = lane >> 4;
    const int K = g.K, nt = K / BK;
    unsigned voffA[2], voffB[2];
#pragma unroll
    for (int i = 0; i < 2; ++i) { int R, C; stage_rc(tid * 16 + i * 8192, R, C); const int Rb = Epi::PERM ? ((R & ~31) + perm32(R & 31)) : R;
        voffA[i] = (unsigned)(R * K + C) * 2u; voffB[i] = (unsigned)(Rb * K + C) * 2u; }
    const size_t kstep = (size_t)(BK * 2);
    const size_t hstep = (size_t)HALF * K * 2;
    const size_t tstep = 2 * hstep;
    const unsigned ldsw = (unsigned)wid * 1024u;
    const int aoff = lds_byte(wr * 64 + fr, fq * 8), boff = lds_byte(wc * 32 + fr, fq * 8);
#define PG8_SA(b, h) (((b) * 2 + (h)) * HTB)
#define PG8_SB(b, h) ((4 + (b) * 2 + (h)) * HTB)
#define PG8_STAGE(bufoff, gbase, voff) do { _Pragma("unroll") for (int _i = 0; _i < 2; ++_i) \
        __builtin_amdgcn_global_load_lds((const unsigned*)((const char*)(gbase) + (voff)[_i]), (PG8_LAS unsigned*)(lds + (bufoff) + ldsw + _i * 8192), 16, 0, 0); } while (0)
#define PG8_LDA(dst, b, h) do { _Pragma("unroll") for (int m = 0; m < 4; ++m) _Pragma("unroll") for (int k = 0; k < 2; ++k) dst[m][k] = *(const PG8_LAS bf16x8*)(lds + PG8_SA(b, h) + aoff + m * 2048 + k * 1024); } while (0)
#define PG8_LDB(dst, b, h) do { _Pragma("unroll") for (int n = 0; n < 2; ++n) _Pragma("unroll") for (int k = 0; k < 2; ++k) dst[n][k] = *(const PG8_LAS bf16x8*)(lds + PG8_SB(b, h) + boff + n * 2048 + k * 1024); } while (0)
#define PG8_MMA(ai, bj, At, Bt) do { __builtin_amdgcn_s_setprio(1); _Pragma("unroll") for (int m = 0; m < 4; ++m) _Pragma("unroll") for (int n = 0; n < 2; ++n) _Pragma("unroll") for (int k = 0; k < 2; ++k) \
        acc[ai][bj][m][n] = __builtin_amdgcn_mfma_f32_16x16x32_bf16(Bt[n][k], At[m][k], acc[ai][bj][m][n], 0, 0, 0); __builtin_amdgcn_s_setprio(0); } while (0)
#define PG8_WAIT_V(n) asm volatile("s_waitcnt vmcnt(" #n ")" ::: "memory")
#define PG8_WAIT_L(n) asm volatile("s_waitcnt lgkmcnt(" #n ")" ::: "memory")
#define PG8_BAR __builtin_amdgcn_s_barrier()
#define PG8_SCHED __builtin_amdgcn_sched_barrier(0)
    Unit cur, nxt; int ui = 0;
    if (!S.next(0, cur)) return;
    f32x4 acc[2][2][4][2];
#pragma unroll
    for (int a = 0; a < 2; ++a)
#pragma unroll
        for (int b = 0; b < 2; ++b)
#pragma unroll
            for (int m = 0; m < 4; ++m)
#pragma unroll
                for (int n = 0; n < 2; ++n) acc[a][b][m][n] = (f32x4){0.f, 0.f, 0.f, 0.f};
    bf16x8 At[4][2], B0[2][2], B1[2][2];
    const char* cA = (const char*)g.A + (size_t)cur.pm * tstep; const char* cB = (const char*)g.Bt + (size_t)cur.pn * tstep;
    S.a_ready(cur);
    if constexpr (SP2) {
        PG8_STAGE(PG8_SB(0, 0), cB, voffB); PG8_STAGE(PG8_SB(0, 1), cB + hstep, voffB); PG8_STAGE(PG8_SA(0, 0), cA, voffA); PG8_STAGE(PG8_SA(0, 1), cA + hstep, voffA);
        if (wr == 1) PG8_BAR;
        PG8_WAIT_V(2); PG8_BAR;
        PG8_STAGE(PG8_SB(1, 0), cB + kstep, voffB); PG8_STAGE(PG8_SA(1, 0), cA + kstep, voffA); PG8_STAGE(PG8_SB(1, 1), cB + hstep + kstep, voffB);
        PG8_WAIT_V(6); PG8_BAR;
    } else {
        PG8_STAGE(PG8_SB(0, 0), cB, voffB); PG8_STAGE(PG8_SA(0, 0), cA, voffA); PG8_STAGE(PG8_SB(0, 1), cB + hstep, voffB); PG8_STAGE(PG8_SA(0, 1), cA + hstep, voffA);
        if (wr == 1) PG8_BAR;
        PG8_WAIT_V(4); PG8_BAR;
        PG8_STAGE(PG8_SB(1, 0), cB + kstep, voffB); PG8_STAGE(PG8_SA(1, 0), cA + kstep, voffA); PG8_STAGE(PG8_SB(1, 1), cB + hstep + kstep, voffB);
        PG8_WAIT_V(6); PG8_BAR;
    }
    for (;;) {
        const bool has_next = S.next(ui + 1, nxt);
        const char* nA = has_next ? (const char*)g.A + (size_t)nxt.pm * tstep : cA; const char* nB = has_next ? (const char*)g.Bt + (size_t)nxt.pn * tstep : cB;
        for (int t = 0; t < nt; t += 2) {
            const bool last = (t == nt - 2);
            const char* a1 = cA + (size_t)(t + 1) * kstep;
            const char* a2 = last ? nA : cA + (size_t)(t + 2) * kstep; const char* b2 = last ? nB : cB + (size_t)(t + 2) * kstep;
            const char* a3 = a2 + kstep; const char* b3 = b2 + kstep;
            if (last && has_next) S.a_ready(nxt);
            if constexpr (SP2) {
            PG8_LDB(B0, 0, 0); PG8_LDB(B1, 0, 1); PG8_SCHED; PG8_LDA(At, 0, 0); PG8_STAGE(PG8_SA(1, 1), a1 + hstep, voffA);
            PG8_WAIT_V(8); PG8_WAIT_L(0); PG8_BAR; PG8_MMA(0, 0, At, B0); PG8_MMA(0, 1, At, B1); PG8_BAR; PG8_SCHED;
            PG8_LDA(At, 0, 1); PG8_STAGE(PG8_SB(0, 0), b2, voffB); PG8_STAGE(PG8_SB(0, 1), b2 + hstep, voffB); PG8_STAGE(PG8_SA(0, 0), a2, voffA);
            PG8_WAIT_V(8); PG8_WAIT_L(0); PG8_BAR; PG8_MMA(1, 0, At, B0); PG8_MMA(1, 1, At, B1); PG8_BAR; PG8_SCHED;
            PG8_LDB(B0, 1, 0); PG8_LDB(B1, 1, 1); PG8_SCHED; PG8_LDA(At, 1, 0); PG8_STAGE(PG8_SA(0, 1), a2 + hstep, voffA);
            PG8_WAIT_V(8); PG8_WAIT_L(0); PG8_BAR; PG8_MMA(0, 0, At, B0); PG8_MMA(0, 1, At, B1); PG8_BAR; PG8_SCHED;
            PG8_LDA(At, 1, 1); PG8_STAGE(PG8_SB(1, 0), b3, voffB); PG8_STAGE(PG8_SB(1, 1), b3 + hstep, voffB); PG8_STAGE(PG8_SA(1, 0), a3, voffA);
            PG8_WAIT_V(8); PG8_WAIT_L(0); PG8_BAR; PG8_MMA(1, 0, At, B0); PG8_MMA(1, 1, At, B1); PG8_BAR; PG8_SCHED;
            } else {
            PG8_LDB(B0, 0, 0); PG8_SCHED; PG8_LDA(At, 0, 0); PG8_STAGE(PG8_SA(1, 1), a1 + hstep, voffA);
            PG8_WAIT_L(8); PG8_BAR; PG8_WAIT_L(0); PG8_MMA(0, 0, At, B0); PG8_BAR; PG8_SCHED;
            PG8_LDB(B1, 0, 1); PG8_STAGE(PG8_SB(0, 0), b2, voffB);
            PG8_BAR; PG8_WAIT_L(0); PG8_MMA(0, 1, At, B1); PG8_BAR;
            PG8_LDA(At, 0, 1); PG8_STAGE(PG8_SA(0, 0), a2, voffA);
            PG8_BAR; PG8_WAIT_L(0); PG8_MMA(1, 0, At, B0); PG8_BAR; PG8_SCHED;
            PG8_STAGE(PG8_SB(0, 1), b2 + hstep, voffB);
            PG8_WAIT_V(6); PG8_BAR; PG8_MMA(1, 1, At, B1); PG8_BAR;
            PG8_LDB(B0, 1, 0); PG8_SCHED; PG8_LDA(At, 1, 0); PG8_STAGE(PG8_SA(0, 1), a2 + hstep, voffA);
            PG8_WAIT_L(8); PG8_BAR; PG8_WAIT_L(0); PG8_MMA(0, 0, At, B0); PG8_BAR; PG8_SCHED;
            PG8_LDB(B1, 1, 1); PG8_STAGE(PG8_SB(1, 0), b3, voffB);
            PG8_BAR; PG8_WAIT_L(0); PG8_MMA(0, 1, At, B1); PG8_BAR;
            PG8_LDA(At, 1, 1); PG8_STAGE(PG8_SA(1, 0), a3, voffA);
            PG8_BAR; PG8_WAIT_L(0); PG8_MMA(1, 0, At, B0); PG8_BAR; PG8_SCHED;
            PG8_STAGE(PG8_SB(1, 1), b3 + hstep, voffB);
            PG8_WAIT_V(6); PG8_BAR; PG8_MMA(1, 1, At, B1); PG8_BAR;
            }
        }
        if constexpr (ALIGN_EPI) { if (wr == 0) PG8_BAR; }
        if constexpr (!Epi::AFTER_DRAIN) { E(acc, cur, wr, wc, fr, fq); S.done(cur); }
        if (!has_next) break;
#pragma unroll
        for (int a = 0; a < 2; ++a)
#pragma unroll
            for (int b = 0; b < 2; ++b)
#pragma unroll
                for (int m = 0; m < 4; ++m)
#pragma unroll
                    for (int n = 0; n < 2; ++n) acc[a][b][m][n] = (f32x4){0.f, 0.f, 0.f, 0.f};
        cur = nxt; cA = nA; cB = nB; ++ui;
        if constexpr (ALIGN_EPI) { if (wr == 1) PG8_BAR; }
    }
    PG8_WAIT_V(0);
    if constexpr (!ALIGN_EPI) { if (wr == 0) PG8_BAR; }
    PG8_BAR;
    if constexpr (Epi::AFTER_DRAIN) { E.fused(acc, cur, wr, wc, fr, fq, lds, wid, lane); S.done(cur); }
#undef PG8_SA
#undef PG8_SB
#undef PG8_STAGE
#undef PG8_LDA
#undef PG8_LDB
#undef PG8_MMA
#undef PG8_WAIT_V
#undef PG8_WAIT_L
#undef PG8_BAR
#undef PG8_SCHED
}
}

using pg8::bf16_t; using pg8::bf16x8; using pg8::f32x4; using pg8::u32x4;
typedef unsigned u32x2 __attribute__((ext_vector_type(2)));
typedef short s16x4 __attribute__((ext_vector_type(4)));
#define LAS __attribute__((address_space(3)))

constexpr int DM = 2048, SEQ = 4096, NT = 8192, NINP = 15872, NIN = 15712, DFF = 8192, NMOD = 12288;
constexpr int ZQ = 0, ZK = 1024, ZV = 2048, ZA = 4096, ZR = 4112, ZQL = 6160, ZKV = 10256, ZIQ = 10512, ZIK = 11536, ZIW = 11600, ZGG = 11616, ZGD = 13664;
constexpr float EPS = 1e-6f;
constexpr int LDS_BYTES = 147456;
constexpr int NPH = 23;

constexpr size_t WS_WIN = 0;
constexpr size_t WS_WOUT = WS_WIN + (size_t)NINP * DM * 2;
constexpr size_t WS_W1 = WS_WOUT + (size_t)DM * DM * 2;
constexpr size_t WS_W2 = WS_W1 + (size_t)DFF * DM * 2;
constexpr size_t WS_WUV = WS_W2 + (size_t)DFF * DM * 2;
constexpr size_t WS_MODP = WS_WUV + (size_t)16 * 128 * 256 * 2;
constexpr size_t WS_MOD = WS_MODP + (size_t)2 * 64 * 2 * NMOD * 4;
constexpr size_t WS_H = WS_MOD + (size_t)2 * 2 * NMOD * 4;
constexpr size_t WS_Z = WS_H + (size_t)NT * DM * 2;
constexpr size_t WS_QT = WS_Z + (size_t)NT * NINP * 2;
constexpr size_t WS_AM = WS_QT + (size_t)NT * 1024 * 2;
constexpr size_t WS_VT = WS_AM + (size_t)512 * 64 * 64 * 2;
constexpr size_t WS_DEC = WS_VT + (size_t)512 * 512 * 64 * 2;
constexpr size_t WS_UT = WS_DEC + (size_t)512 * 256 * 4;
constexpr size_t WS_KVN = WS_UT + (size_t)512 * 512 * 256 * 2;
constexpr size_t WS_SC = WS_KVN + (size_t)NT * 256 * 2;
constexpr size_t WS_IDX = WS_SC + (size_t)NT * 4096 * 4;
constexpr size_t WS_MRG = WS_IDX + (size_t)NT * 256 * 4;
constexpr size_t WS_END = WS_MRG + (size_t)NT * DM * 2;

struct Params {
    const float *x, *c, *w_mod, *b_mod, *norm1_g, *w_in, *w_gate_up, *b_gate, *gla_norm_g, *kv_norm_g, *w_uv, *w_out, *norm2_g, *w_ff1, *w_ff2, *rel_bias, *final_g;
    float* out; unsigned char* ws; int ph_lo, ph_hi;
};

__device__ __forceinline__ unsigned f2bf(float f) { unsigned u = __builtin_bit_cast(unsigned, f); return (u + 0x7fffu + ((u >> 16) & 1u)) >> 16; }
__device__ __forceinline__ unsigned pk2(float lo, float hi) { return f2bf(lo) | (f2bf(hi) << 16); }
__device__ __forceinline__ float bf2f(unsigned v) { return __builtin_bit_cast(float, v << 16); }
__device__ __forceinline__ float wave_sum(float v) {
#pragma unroll
    for (int o = 1; o < 64; o <<= 1) v += __shfl_xor(v, o);
    return v;
}
#define LDS_WAIT() asm volatile("s_waitcnt lgkmcnt(0)" ::: "memory")
__device__ __forceinline__ float sigmoidf_(float x) { return 1.f / (1.f + __expf(-x)); }
__device__ __forceinline__ float logsig(float x) { return fminf(x, 0.f) - log1pf(expf(-fabsf(x))); }

template <int ACT> struct EpiStoreBf16 {
    static constexpr bool PERM = true, AFTER_DRAIN = false;
    bf16_t* O; int ldc;
    __device__ __forceinline__ void operator()(const f32x4 (&acc)[2][2][4][2], const pg8::Unit& u, int wr, int wc, int fr, int fq) const {
        const int row0 = u.pm * 256 + wr * 64 + fr, col0 = u.pn * 256 + wc * 32 + 8 * fq;
#pragma unroll
        for (int ai = 0; ai < 2; ++ai)
#pragma unroll
            for (int m = 0; m < 4; ++m) { bf16_t* rowp = O + (size_t)(row0 + ai * 128 + m * 16) * ldc + col0;
#pragma unroll
                for (int bj = 0; bj < 2; ++bj) { f32x4 v0 = acc[ai][bj][m][0], v1 = acc[ai][bj][m][1];
                    if (ACT == 1) {
#pragma unroll
                        for (int e = 0; e < 4; ++e) { float a = fmaxf(v0[e], 0.f), b = fmaxf(v1[e], 0.f); v0[e] = a * a; v1[e] = b * b; } }
                    u32x4 w; w.x = pk2(v0[0], v0[1]); w.y = pk2(v0[2], v0[3]); w.z = pk2(v1[0], v1[1]); w.w = pk2(v1[2], v1[3]);
                    *(u32x4*)(rowp + bj * 128) = w; } }
    }
};
struct EpiResidual {
    static constexpr bool PERM = false, AFTER_DRAIN = false;
    const float* base; float* out; const float* gate;
    __device__ __forceinline__ void operator()(const f32x4 (&acc)[2][2][4][2], const pg8::Unit& u, int wr, int wc, int fr, int fq) const {
        const int col0 = u.pn * 256 + wc * 32 + 4 * fq; const float* gb = gate + (size_t)((u.pm * 256) >> 12) * NMOD;
#pragma unroll
        for (int ai = 0; ai < 2; ++ai)
#pragma unroll
            for (int m = 0; m < 4; ++m) { const size_t off = (size_t)(u.pm * 256 + ai * 128 + wr * 64 + m * 16 + fr) * DM;
#pragma unroll
                for (int bj = 0; bj < 2; ++bj)
#pragma unroll
                    for (int n = 0; n < 2; ++n) { const int c = col0 + bj * 128 + n * 16; const f32x4 gv = *(const f32x4*)(gb + c), bs = *(const f32x4*)(base + off + c);
                        *(f32x4*)(out + off + c) = bs + gv * acc[ai][bj][m][n]; } }
    }
};

__device__ __forceinline__ void transpose_item(const float* __restrict__ W, int K, int N, bf16_t* __restrict__ WT, float* scr, int item, int lane) {
    const int nblk = N / 32, kb = item / nblk, nb = item % nblk, k0 = 64 * kb, n0 = 32 * nb;
#pragma unroll 8
    for (int i = 0; i < 32; ++i) { const int kk = 2 * i + (lane >> 5); scr[kk * 33 + (lane & 31)] = W[(size_t)(k0 + kk) * N + n0 + (lane & 31)]; }
    LDS_WAIT();
    const int c = lane & 7;
#pragma unroll
    for (int j = 0; j < 4; ++j) { const int n = (lane >> 3) + 8 * j; const float* s = scr + (8 * c) * 33 + n;
        u32x4 o; o.x = pk2(s[0 * 33], s[1 * 33]); o.y = pk2(s[2 * 33], s[3 * 33]); o.z = pk2(s[4 * 33], s[5 * 33]); o.w = pk2(s[6 * 33], s[7 * 33]);
        *(u32x4*)(WT + (size_t)(n0 + n) * K + k0 + 8 * c) = o; }
    LDS_WAIT();
}
__device__ __forceinline__ void phase_convert(const Params& p, int l, unsigned char* smem) {
    const int tid = TIDX(), lane = tid & 63, wave = tid >> 6;
    float* scr = (float*)(smem + 16384 + wave * 8448);
    const int gw = BIDX() * 8 + wave, NGW = gridDim.x * 8;
    bf16_t* WinT = (bf16_t*)(p.ws + WS_WIN); bf16_t* WoutT = (bf16_t*)(p.ws + WS_WOUT); bf16_t* W1T = (bf16_t*)(p.ws + WS_W1); bf16_t* W2T = (bf16_t*)(p.ws + WS_W2); bf16_t* WuvT = (bf16_t*)(p.ws + WS_WUV);
    constexpr int I_IN = 32 * (NIN / 32), I_OUT = 32 * 64, I_1 = 32 * 256, I_2 = 128 * 64, I_UV = 16 * 16;
    constexpr int NITEMS = I_IN + I_OUT + I_1 + I_2 + I_UV;
    for (int it = gw; it < NITEMS; it += NGW) {
        int r = it;
        if (r < I_IN) { transpose_item(p.w_in + (size_t)l * DM * NIN, DM, NIN, WinT, scr, r, lane); continue; } r -= I_IN;
        if (r < I_OUT) { transpose_item(p.w_out + (size_t)l * DM * DM, DM, DM, WoutT, scr, r, lane); continue; } r -= I_OUT;
        if (r < I_1) { transpose_item(p.w_ff1 + (size_t)l * DM * DFF, DM, DFF, W1T, scr, r, lane); continue; } r -= I_1;
        if (r < I_2) { transpose_item(p.w_ff2 + (size_t)l * DFF * DM, DFF, DM, W2T, scr, r, lane); continue; } r -= I_2;
        { const int hh = r >> 4, ri = r & 15; transpose_item(p.w_uv + ((size_t)l * 16 + hh) * 256 * 128, 256, 128, WuvT + (size_t)hh * 128 * 256, scr, ri, lane); }
    }
    const int gt = BIDX() * 512 + tid, NGT = gridDim.x * 512;
    for (int i = gt; i < (NINP - NIN) * DM / 8; i += NGT) *(u32x4*)(WinT + (size_t)NIN * DM + (size_t)i * 8) = (u32x4){0u, 0u, 0u, 0u};
}
__device__ __forceinline__ void phase_modp(const Params& p, unsigned char* smem) {
    const int tid = TIDX(), lane = tid & 63, wave = tid >> 6;
    float* ca = (float*)smem;
    for (int i = tid; i < 2 * DM; i += 512) { const float v = p.c[i]; ca[i] = v / (1.f + expf(-v)); }
    __syncthreads();
    float* MODP = (float*)(p.ws + WS_MODP);
    const int gw = BIDX() * 8 + wave, NGW = gridDim.x * 8;
    for (int u = gw; u < 2 * 48 * 64; u += NGW) {
        const int l = u / (48 * 64), r = u % (48 * 64), cgp = r >> 6, kc = r & 63;
        const float* W = p.w_mod + (size_t)l * DM * NMOD + (size_t)(kc * 32) * NMOD + cgp * 256 + lane * 4;
        f32x4 a0 = {0.f, 0.f, 0.f, 0.f}, a1 = {0.f, 0.f, 0.f, 0.f};
#pragma unroll 8
        for (int rr = 0; rr < 32; ++rr) { const f32x4 w = *(const f32x4*)(W + (size_t)rr * NMOD); const float c0 = ca[kc * 32 + rr], c1 = ca[DM + kc * 32 + rr]; a0 += c0 * w; a1 += c1 * w; }
        float* o = MODP + ((size_t)(l * 64 + kc) * 2) * NMOD + cgp * 256 + lane * 4;
        *(f32x4*)o = a0; *(f32x4*)(o + NMOD) = a1;
    }
}
__device__ __forceinline__ void phase_modreduce(const Params& p) {
    const int gt = BIDX() * 512 + TIDX();
    const float* MODP = (const float*)(p.ws + WS_MODP); float* MOD = (float*)(p.ws + WS_MOD);
    for (int i = gt; i < 2 * 2 * NMOD; i += gridDim.x * 512) {
        const int l = i / (2 * NMOD), b = (i / NMOD) & 1, j = i % NMOD;
        float s = p.b_mod[l * NMOD + j];
        for (int kc = 0; kc < 64; ++kc) s += MODP[((size_t)(l * 64 + kc) * 2 + b) * NMOD + j];
        MOD[i] = s;
    }
}

__device__ __forceinline__ void phase_norm(const float* X, const float* g, const float* sh, const float* sc, bf16_t* H) {
    const int lane = TIDX() & 63, wave = TIDX() >> 6;
    for (int row = BIDX() * 8 + wave; row < NT; row += gridDim.x * 8) {
        const int b = row >> 12; const float* xr = X + (size_t)row * DM + lane * 4;
        f32x4 v[8]; float ss = 0.f;
#pragma unroll
        for (int j = 0; j < 8; ++j) { v[j] = *(const f32x4*)(xr + j * 256); ss += (v[j][0] * v[j][0] + v[j][1] * v[j][1]) + (v[j][2] * v[j][2] + v[j][3] * v[j][3]); }
        const float rstd = rsqrtf(wave_sum(ss) * (1.f / DM) + EPS);
#pragma unroll
        for (int j = 0; j < 8; ++j) { const int c = j * 256 + lane * 4; const f32x4 gv = *(const f32x4*)(g + c), sv = *(const f32x4*)(sc + (size_t)b * NMOD + c), hv = *(const f32x4*)(sh + (size_t)b * NMOD + c);
            const f32x4 o = (v[j] * rstd * gv) * (1.f + sv) + hv; u32x2 w; w.x = pk2(o[0], o[1]); w.y = pk2(o[2], o[3]);
            *(u32x2*)(H + (size_t)row * DM + c) = w; }
    }
}
__device__ __forceinline__ void phase_final(const float* X, const float* g, float* out) {
    const int lane = TIDX() & 63, wave = TIDX() >> 6;
    for (int row = BIDX() * 8 + wave; row < NT; row += gridDim.x * 8) {
        const float* xr = X + (size_t)row * DM + lane * 4;
        f32x4 v[8]; float ss = 0.f;
#pragma unroll
        for (int j = 0; j < 8; ++j) { v[j] = *(const f32x4*)(xr + j * 256); ss += (v[j][0] * v[j][0] + v[j][1] * v[j][1]) + (v[j][2] * v[j][2] + v[j][3] * v[j][3]); }
        const float rstd = rsqrtf(wave_sum(ss) * (1.f / DM) + EPS);
#pragma unroll
        for (int j = 0; j < 8; ++j) { const int c = j * 256 + lane * 4; const f32x4 gv = *(const f32x4*)(g + c); *(f32x4*)(out + (size_t)row * DM + c) = v[j] * rstd * gv; }
    }
}

#define MFMA16(a, b, c) __builtin_amdgcn_mfma_f32_16x16x32_bf16((a), (b), (c), 0, 0, 0)
__device__ __forceinline__ void gla1_unit(const Params& p, int l, int u, unsigned char* smem) {
    const int tid = TIDX(), lane = tid & 63, wave = tid >> 6, fr = lane & 15, fq = lane >> 4;
    const int b = u >> 8, c = (u >> 2) & 63, h = u & 3, t0 = b * SEQ + c * 64;
    const bf16_t* Z = (const bf16_t*)(p.ws + WS_Z);
    float* AL = (float*)smem;
    float* TOT = (float*)(smem + 4096);
    bf16_t* KST = (bf16_t*)(smem + 6144);
    bf16_t* QS = (bf16_t*)(smem + 43008);
    bf16_t* KI = (bf16_t*)(smem + 76800);
    bf16_t* VT = (bf16_t*)(smem + 43008);
    bf16_t* QT = (bf16_t*)(p.ws + WS_QT); bf16_t* AM = (bf16_t*)(p.ws + WS_AM); bf16_t* VTG = (bf16_t*)(p.ws + WS_VT); float* DEC = (float*)(p.ws + WS_DEC); bf16_t* UT = (bf16_t*)(p.ws + WS_UT);
    for (int i = tid; i < 1024; i += 512) AL[i] = bf2f(Z[(size_t)(t0 + (i >> 4)) * NINP + ZA + (i & 15)]);
    const int d = tid & 255, half = tid >> 8;
    float w[16];
#pragma unroll
    for (int r = 0; r < 16; ++r) w[r] = p.w_gate_up[((size_t)l * 16 + r) * 1024 + h * 256 + d];
    const float bias = p.b_gate[l * 1024 + h * 256 + d];
    __syncthreads();
    {   float sum = 0.f;
        for (int pos = half * 32; pos < half * 32 + 32; ++pos) { float x = bias;
#pragma unroll
            for (int r = 0; r < 16; ++r) x += AL[pos * 16 + r] * w[r];
            sum += logsig(x) * (1.f / 16.f); }
        TOT[half * 256 + d] = sum; }
    __syncthreads();
    {   const float blast = TOT[d] + TOT[256 + d]; float run = half ? TOT[d] : 0.f;
        const bf16_t* zq = Z + (size_t)(t0 + half * 32) * NINP + ZQ + h * 256 + d; const bf16_t* zk = zq + (ZK - ZQ);
        bf16_t* qtg = QT + ((size_t)(b * 4 + h) * SEQ + c * 64 + half * 32) * 256 + d;
        for (int p8 = 0; p8 < 4; ++p8) { unsigned ks[8];
#pragma unroll
            for (int e = 0; e < 8; ++e) { const int pl = p8 * 8 + e, pos = half * 32 + pl; float x = bias;
#pragma unroll
                for (int r = 0; r < 16; ++r) x += AL[pos * 16 + r] * w[r];
                run += logsig(x) * (1.f / 16.f);
                const float qv = bf2f(zq[(size_t)pl * NINP]), kv = bf2f(zk[(size_t)pl * NINP]);
                const unsigned qb = f2bf(qv * 0.0625f * expf(run));
                QS[pos * 264 + d] = (bf16_t)qb; qtg[(size_t)pl * 256] = (bf16_t)qb;
                KI[pos * 264 + d] = (bf16_t)f2bf(kv * expf(-run));
                ks[e] = f2bf(kv * expf(blast - run)); }
            u32x4 o; o.x = ks[0] | (ks[1] << 16); o.y = ks[2] | (ks[3] << 16); o.z = ks[4] | (ks[5] << 16); o.w = ks[6] | (ks[7] << 16);
            *(u32x4*)(KST + d * 72 + half * 32 + p8 * 8) = o; }
        if (half == 0) DEC[u * 256 + d] = expf(blast); }
    __syncthreads();
#pragma unroll
    for (int tt = 0; tt < 2; ++tt) { const int id = wave * 2 + tt, it = id >> 2, jt = id & 3; f32x4 acc = {0.f, 0.f, 0.f, 0.f};
        if (jt <= it) {
#pragma unroll
            for (int s = 0; s < 8; ++s) { const bf16x8 a = *(const bf16x8*)(QS + (it * 16 + fr) * 264 + 32 * s + 8 * fq), bb = *(const bf16x8*)(KI + (jt * 16 + fr) * 264 + 32 * s + 8 * fq);
                acc = MFMA16(a, bb, acc); } }
#pragma unroll
        for (int r = 0; r < 4; ++r) { const int i = it * 16 + 4 * fq + r, j = jt * 16 + fr; AM[(size_t)u * 4096 + i * 64 + j] = (bf16_t)f2bf(j <= i ? acc[r] : 0.f); } }
    __syncthreads();
    {   const int dv = tid; const bf16_t* zv = Z + (size_t)t0 * NINP + ZV + h * 512 + dv;
        for (int p8 = 0; p8 < 8; ++p8) { unsigned vv[8];
#pragma unroll
            for (int e = 0; e < 8; ++e) vv[e] = zv[(size_t)(p8 * 8 + e) * NINP];
            u32x4 o; o.x = vv[0] | (vv[1] << 16); o.y = vv[2] | (vv[3] << 16); o.z = vv[4] | (vv[5] << 16); o.w = vv[6] | (vv[7] << 16);
            *(u32x4*)(VT + dv * 72 + p8 * 8) = o; *(u32x4*)(VTG + (size_t)u * 32768 + dv * 64 + p8 * 8) = o; } }
    __syncthreads();
    {   bf16x8 bfr[4][2];
#pragma unroll
        for (int nt = 0; nt < 4; ++nt)
#pragma unroll
            for (int s = 0; s < 2; ++s) bfr[nt][s] = *(const bf16x8*)(VT + (wave * 64 + nt * 16 + fr) * 72 + 32 * s + 8 * fq);
        for (int mt = 0; mt < 16; ++mt) { const bf16x8 a0 = *(const bf16x8*)(KST + (mt * 16 + fr) * 72 + 8 * fq), a1 = *(const bf16x8*)(KST + (mt * 16 + fr) * 72 + 32 + 8 * fq);
#pragma unroll
            for (int nt = 0; nt < 4; ++nt) { f32x4 acc = {0.f, 0.f, 0.f, 0.f}; acc = MFMA16(a0, bfr[nt][0], acc); acc = MFMA16(a1, bfr[nt][1], acc);
                u32x2 o; o.x = pk2(acc[0], acc[1]); o.y = pk2(acc[2], acc[3]);
                *(u32x2*)(UT + (size_t)u * 131072 + (size_t)(wave * 64 + nt * 16 + fr) * 256 + mt * 16 + 4 * fq) = o; } } }
    __syncthreads();
}

__device__ __forceinline__ void phase_gla_scan(const Params& p) {
    bf16_t* UT = (bf16_t*)(p.ws + WS_UT); const float* DEC = (const float*)(p.ws + WS_DEC);
    for (int gid = BIDX() * 512 + TIDX(); gid < 131072; gid += gridDim.x * 512) {
        const int bh = gid >> 14, b = bh >> 2, h = bh & 3, e = (gid & 16383) * 8, d0 = e & 255;
        float s[8];
#pragma unroll
        for (int i = 0; i < 8; ++i) s[i] = 0.f;
        for (int c4 = 0; c4 < 64; c4 += 4) { u32x4 uu[4]; f32x4 da[4], db[4];
#pragma unroll
            for (int k = 0; k < 4; ++k) { const int u = (b * 64 + c4 + k) * 4 + h; uu[k] = *(const u32x4*)(UT + (size_t)u * 131072 + e); da[k] = *(const f32x4*)(DEC + u * 256 + d0); db[k] = *(const f32x4*)(DEC + u * 256 + d0 + 4); }
#pragma unroll
            for (int k = 0; k < 4; ++k) { const int u = (b * 64 + c4 + k) * 4 + h;
                u32x4 o; o.x = pk2(s[0], s[1]); o.y = pk2(s[2], s[3]); o.z = pk2(s[4], s[5]); o.w = pk2(s[6], s[7]);
                *(u32x4*)(UT + (size_t)u * 131072 + e) = o;
                s[0] = da[k][0] * s[0] + bf2f(uu[k][0] & 0xffffu); s[1] = da[k][1] * s[1] + bf2f(uu[k][0] >> 16);
                s[2] = da[k][2] * s[2] + bf2f(uu[k][1] & 0xffffu); s[3] = da[k][3] * s[3] + bf2f(uu[k][1] >> 16);
                s[4] = db[k][0] * s[4] + bf2f(uu[k][2] & 0xffffu); s[5] = db[k][1] * s[5] + bf2f(uu[k][2] >> 16);
                s[6] = db[k][2] * s[6] + bf2f(uu[k][3] & 0xffffu); s[7] = db[k][3] * s[7] + bf2f(uu[k][3] >> 16); } }
    }
}

__device__ __forceinline__ void gla3_unit(const Params& p, int l, int u, unsigned char* smem) {
    const int tid = TIDX(), lane = tid & 63, wave = tid >> 6, fr = lane & 15, fq = lane >> 4;
    const int b = u >> 8, c = (u >> 2) & 63, h = u & 3, t0 = b * SEQ + c * 64;
    const bf16_t* Z = (const bf16_t*)(p.ws + WS_Z);
    bf16_t* QS = (bf16_t*)smem;
    bf16_t* AS = (bf16_t*)(smem + 33792);
    float* RED = (float*)(smem + 43008);
    float* RSTD = (float*)(smem + 45056);
    const bf16_t* QT = (const bf16_t*)(p.ws + WS_QT) + ((size_t)(b * 4 + h) * SEQ + c * 64) * 256; const bf16_t* AM = (const bf16_t*)(p.ws + WS_AM) + (size_t)u * 4096;
    const bf16_t* VTG = (const bf16_t*)(p.ws + WS_VT) + (size_t)u * 32768; const bf16_t* ST = (const bf16_t*)(p.ws + WS_UT) + (size_t)u * 131072; bf16_t* MRG = (bf16_t*)(p.ws + WS_MRG);
#pragma unroll
    for (int k = 0; k < 4; ++k) { const int i = tid + 512 * k, row = i >> 5, ch = i & 31; *(u32x4*)(QS + row * 264 + ch * 8) = *(const u32x4*)(QT + row * 256 + ch * 8); }
    { const int row = tid >> 3, ch = tid & 7; *(u32x4*)(AS + row * 72 + ch * 8) = *(const u32x4*)(AM + row * 64 + ch * 8); }
    __syncthreads();
    const int dv0 = wave * 64;
    f32x4 acc[4][4];
#pragma unroll
    for (int mt = 0; mt < 4; ++mt)
#pragma unroll
        for (int nt = 0; nt < 4; ++nt) acc[mt][nt] = (f32x4){0.f, 0.f, 0.f, 0.f};
    for (int s = 0; s < 8; ++s) { bf16x8 a[4], bb[4];
#pragma unroll
        for (int mt = 0; mt < 4; ++mt) a[mt] = *(const bf16x8*)(QS + (mt * 16 + fr) * 264 + 32 * s + 8 * fq);
#pragma unroll
        for (int nt = 0; nt < 4; ++nt) bb[nt] = *(const bf16x8*)(ST + (size_t)(dv0 + nt * 16 + fr) * 256 + 32 * s + 8 * fq);
#pragma unroll
        for (int mt = 0; mt < 4; ++mt)
#pragma unroll
            for (int nt = 0; nt < 4; ++nt) acc[mt][nt] = MFMA16(a[mt], bb[nt], acc[mt][nt]); }
#pragma unroll
    for (int s = 0; s < 2; ++s) { bf16x8 a[4], bb[4];
#pragma unroll
        for (int mt = 0; mt < 4; ++mt) a[mt] = *(const bf16x8*)(AS + (mt * 16 + fr) * 72 + 32 * s + 8 * fq);
#pragma unroll
        for (int nt = 0; nt < 4; ++nt) bb[nt] = *(const bf16x8*)(VTG + (dv0 + nt * 16 + fr) * 64 + 32 * s + 8 * fq);
#pragma unroll
        for (int mt = 0; mt < 4; ++mt)
#pragma unroll
            for (int nt = 0; nt < 4; ++nt) acc[mt][nt] = MFMA16(a[mt], bb[nt], acc[mt][nt]); }
#pragma unroll
    for (int mt = 0; mt < 4; ++mt)
#pragma unroll
        for (int r = 0; r < 4; ++r) { float ss = 0.f;
#pragma unroll
            for (int nt = 0; nt < 4; ++nt) ss += acc[mt][nt][r] * acc[mt][nt][r];
            ss += __shfl_xor(ss, 1); ss += __shfl_xor(ss, 2); ss += __shfl_xor(ss, 4); ss += __shfl_xor(ss, 8);
            if (fr == 0) RED[wave * 64 + mt * 16 + 4 * fq + r] = ss; }
    __syncthreads();
    if (tid < 64) { float t = 0.f;
#pragma unroll
        for (int w8 = 0; w8 < 8; ++w8) t += RED[w8 * 64 + tid];
        RSTD[tid] = rsqrtf(t * (1.f / 512.f) + EPS); }
    __syncthreads();
    const float* gn = p.gla_norm_g + l * 512;
#pragma unroll
    for (int mt = 0; mt < 4; ++mt)
#pragma unroll
        for (int r = 0; r < 4; ++r) { const int i = mt * 16 + 4 * fq + r; const float rs = RSTD[i]; const size_t t = (size_t)(t0 + i);
#pragma unroll
            for (int nt = 0; nt < 4; ++nt) { const int dv = dv0 + nt * 16 + fr, col = h * 512 + dv;
                const float rv = bf2f(Z[t * NINP + ZR + col]), gv = bf2f(Z[t * NINP + ZGG + col]);
                const float y = acc[mt][nt][r] * rs * gn[dv] * (rv * sigmoidf_(rv)) * sigmoidf_(gv);
                MRG[t * DM + col] = (bf16_t)f2bf(y); } }
    __syncthreads();
}

__device__ __forceinline__ void phase_kvnorm(const Params& p, int l) {
    const int lane = TIDX() & 63, wave = TIDX() >> 6;
    const bf16_t* Z = (const bf16_t*)(p.ws + WS_Z); bf16_t* KVN = (bf16_t*)(p.ws + WS_KVN);
    const f32x4 gv = *(const f32x4*)(p.kv_norm_g + l * 256 + lane * 4);
    for (int row = BIDX() * 8 + wave; row < NT; row += gridDim.x * 8) {
        const u32x2 raw = *(const u32x2*)(Z + (size_t)row * NINP + ZKV + lane * 4);
        const float v0 = bf2f(raw.x & 0xffffu), v1 = bf2f(raw.x >> 16), v2 = bf2f(raw.y & 0xffffu), v3 = bf2f(raw.y >> 16);
        const float rstd = rsqrtf(wave_sum((v0 * v0 + v1 * v1) + (v2 * v2 + v3 * v3)) * (1.f / 256.f) + EPS);
        u32x2 o; o.x = pk2(v0 * rstd * gv[0], v1 * rstd * gv[1]); o.y = pk2(v2 * rstd * gv[2], v3 * rstd * gv[3]);
        *(u32x2*)(KVN + (size_t)row * 256 + lane * 4) = o;
    }
}
__device__ __forceinline__ void score_unit(const Params& p, int u) {
    const int lane = TIDX() & 63, wave = TIDX() >> 6, fr = lane & 15, fq = lane >> 4;
    const int b = u / 528, i = u % 528; int qt = 0; while ((qt + 1) * (qt + 2) / 2 <= i) ++qt; const int kt = i - qt * (qt + 1) / 2;
    const bf16_t* Z = (const bf16_t*)(p.ws + WS_Z); float* SC = (float*)(p.ws + WS_SC);
    const size_t tq = (size_t)b * SEQ + qt * 128 + wave * 16 + fr, tk0 = (size_t)b * SEQ + kt * 128;
    bf16x8 ak[8][2];
#pragma unroll
    for (int m = 0; m < 8; ++m)
#pragma unroll
        for (int s = 0; s < 2; ++s) ak[m][s] = *(const bf16x8*)(Z + (tk0 + m * 16 + fr) * NINP + ZIK + 32 * s + 8 * fq);
    f32x4 sc[8];
#pragma unroll
    for (int m = 0; m < 8; ++m) sc[m] = (f32x4){0.f, 0.f, 0.f, 0.f};
#pragma unroll 1
    for (int hh = 0; hh < 16; ++hh) {
        const bf16x8 b0 = *(const bf16x8*)(Z + tq * NINP + ZIQ + hh * 64 + 8 * fq), b1 = *(const bf16x8*)(Z + tq * NINP + ZIQ + hh * 64 + 32 + 8 * fq);
        const float wgt = bf2f(Z[tq * NINP + ZIW + hh]) * (0.25f * 0.125f);
#pragma unroll
        for (int m = 0; m < 8; ++m) { f32x4 acc = {0.f, 0.f, 0.f, 0.f}; acc = MFMA16(ak[m][0], b0, acc); acc = MFMA16(ak[m][1], b1, acc);
#pragma unroll
            for (int r = 0; r < 4; ++r) sc[m][r] += wgt * fmaxf(acc[r], 0.f); }
    }
#pragma unroll
    for (int m = 0; m < 8; ++m) *(f32x4*)(SC + tq * SEQ + kt * 128 + m * 16 + 4 * fq) = sc[m];
}
__device__ __forceinline__ void phase_topk(const Params& p) {
    const int lane = TIDX() & 63, wave = TIDX() >> 6;
    const float* SC = (const float*)(p.ws + WS_SC); int* IDX = (int*)(p.ws + WS_IDX);
    for (int t = BIDX() * 8 + wave; t < NT; t += gridDim.x * 8) {
        const int nv = (t & (SEQ - 1)) + 1; int* out = IDX + (size_t)t * 256;
        if (nv <= 256) { for (int k = lane; k < 256; k += 64) out[k] = k < nv ? k : -1; continue; }
        const float* row = SC + (size_t)t * SEQ; const int nj = (nv + 63) >> 6;
        unsigned key[64];
#pragma unroll
        for (int j = 0; j < 64; ++j) { unsigned k = 0u; const int e = j * 64 + lane;
            if (j < nj && e < nv) { const unsigned uu = __builtin_bit_cast(unsigned, row[e]); k = (uu & 0x80000000u) ? ~uu : (uu | 0x80000000u); }
            key[j] = k; }
        unsigned thr = 0u;
        for (int bit = 31; bit >= 0; --bit) { const unsigned cand = thr | (1u << bit); int cnt = 0;
#pragma unroll
            for (int j = 0; j < 64; ++j) cnt += __popcll(__ballot(key[j] >= cand));
            if (cnt >= 256) thr = cand; }
        int cgt = 0;
#pragma unroll
        for (int j = 0; j < 64; ++j) cgt += __popcll(__ballot(key[j] > thr));
        const int need = 256 - cgt; int base = 0, eqb = 0;
        const unsigned long long lt = (1ull << lane) - 1ull;
#pragma unroll
        for (int j = 0; j < 64; ++j) { const bool gt = key[j] > thr, eq = key[j] == thr; const unsigned long long meq = __ballot(eq);
            const bool sel = gt || (eq && (eqb + __popcll(meq & lt)) < need); const unsigned long long ms = __ballot(sel);
            if (sel) out[base + __popcll(ms & lt)] = j * 64 + lane;
            base += __popcll(ms); eqb += __popcll(meq); }
    }
}
__device__ __forceinline__ s16x4 tr_read(const unsigned char* pl) {
    typedef short v4i16_t __attribute__((ext_vector_type(4)));
    return __builtin_bit_cast(s16x4, __builtin_amdgcn_ds_read_tr16_b64_v4i16((LAS v4i16_t*)(pl)));
}
__device__ __forceinline__ int rel_bucket(int rel) {
    if (rel < 16) return rel;
    const int v = 16 + (int)(log2f((float)rel * 0.0625f) * (16.f / 3.f));
    return v < 31 ? v : 31;
}
__device__ __forceinline__ void phase_attn(const Params& p, unsigned char* smem) {
    const int tid = TIDX(), lane = tid & 63, wave = tid >> 6, fr = lane & 15, fq = lane >> 4;
    const bf16_t* Z = (const bf16_t*)(p.ws + WS_Z); const bf16_t* KVN = (const bf16_t*)(p.ws + WS_KVN); const int* IDX = (const int*)(p.ws + WS_IDX); bf16_t* OLAT = (bf16_t*)(p.ws + WS_SC);
    float* BT = (float*)(smem + 135168);
    BT[tid] = p.rel_bias[tid];
    __syncthreads();
    unsigned char* kvl = smem + wave * 16896;
    const int q4 = (lane & 15) >> 2, p4 = lane & 3;
    for (int t = BIDX() * 8 + wave; t < NT; t += gridDim.x * 8) {
        const int tb = t & (SEQ - 1), nsel = tb + 1 < 256 ? tb + 1 : 256, nch = (nsel + 31) >> 5; const size_t bbase = (size_t)(t - tb);
        bf16x8 qf[8];
#pragma unroll
        for (int s = 0; s < 8; ++s) qf[s] = *(const bf16x8*)(Z + (size_t)t * NINP + ZQL + fr * 256 + 32 * s + 8 * fq);
        f32x4 O[16];
#pragma unroll
        for (int c = 0; c < 16; ++c) O[c] = (f32x4){0.f, 0.f, 0.f, 0.f};
        float m_run = -__builtin_inff(), l_run = 0.f;
        for (int ch = 0; ch < nch; ++ch) {
            const int myidx = IDX[(size_t)t * 256 + ch * 32 + (lane & 31)];
            LDS_WAIT();
#pragma unroll
            for (int r = 0; r < 16; ++r) { const int row = 2 * r + (lane >> 5); int ridx = __shfl(myidx, row); ridx = ridx < 0 ? 0 : ridx;
                const u32x4 v = *(const u32x4*)(KVN + (bbase + ridx) * 256 + (lane & 31) * 8);
                *(u32x4*)(kvl + row * 528 + (lane & 31) * 16) = v; }
            LDS_WAIT();
            f32x4 s0 = {0.f, 0.f, 0.f, 0.f}, s1 = {0.f, 0.f, 0.f, 0.f};
#pragma unroll
            for (int s = 0; s < 8; ++s) { const bf16x8 a0 = *(const bf16x8*)(kvl + fr * 528 + (4 * s + fq) * 16), a1 = *(const bf16x8*)(kvl + (16 + fr) * 528 + (4 * s + fq) * 16);
                s0 = MFMA16(a0, qf[s], s0); s1 = MFMA16(a1, qf[s], s1); }
            float lg0[4], lg1[4]; float cmax = -__builtin_inff();
#pragma unroll
            for (int r = 0; r < 4; ++r) { const int i0 = __shfl(myidx, 4 * fq + r), i1 = __shfl(myidx, 16 + 4 * fq + r);
                lg0[r] = i0 >= 0 ? s0[r] * 0.0625f + BT[rel_bucket(tb - i0) * 16 + fr] : -__builtin_inff();
                lg1[r] = i1 >= 0 ? s1[r] * 0.0625f + BT[rel_bucket(tb - i1) * 16 + fr] : -__builtin_inff();
                cmax = fmaxf(cmax, fmaxf(lg0[r], lg1[r])); }
            cmax = fmaxf(cmax, __shfl_xor(cmax, 16)); cmax = fmaxf(cmax, __shfl_xor(cmax, 32));
            const float m_new = fmaxf(m_run, cmax), alpha = __expf(m_run - m_new);
            float ps = 0.f; float pp[8];
#pragma unroll
            for (int r = 0; r < 4; ++r) { pp[r] = __expf(lg0[r] - m_new); pp[4 + r] = __expf(lg1[r] - m_new); ps += pp[r] + pp[4 + r]; }
            l_run = l_run * alpha + ps; m_run = m_new;
            u32x4 pw; pw.x = pk2(pp[0], pp[1]); pw.y = pk2(pp[2], pp[3]); pw.z = pk2(pp[4], pp[5]); pw.w = pk2(pp[6], pp[7]);
            const bf16x8 pb = __builtin_bit_cast(bf16x8, pw);
#pragma unroll
            for (int c = 0; c < 16; ++c) {
                const s16x4 v0 = tr_read(kvl + (4 * fq + q4) * 528 + 32 * c + 8 * p4), v1 = tr_read(kvl + (16 + 4 * fq + q4) * 528 + 32 * c + 8 * p4);
                bf16x8 af; af[0] = v0[0]; af[1] = v0[1]; af[2] = v0[2]; af[3] = v0[3]; af[4] = v1[0]; af[5] = v1[1]; af[6] = v1[2]; af[7] = v1[3];
                O[c] = MFMA16(af, pb, O[c] * alpha); }
        }
        float lt = l_run; lt += __shfl_xor(lt, 16); lt += __shfl_xor(lt, 32);
        const float inv = 1.f / lt;
#pragma unroll
        for (int c = 0; c < 16; ++c) { u32x2 o; o.x = pk2(O[c][0] * inv, O[c][1] * inv); o.y = pk2(O[c][2] * inv, O[c][3] * inv);
            *(u32x2*)(OLAT + (size_t)t * 4096 + fr * 256 + 16 * c + 4 * fq) = o; }
    }
}
__device__ __forceinline__ void upproj_unit(const Params& p, int u) {
    const int lane = TIDX() & 63, wave = TIDX() >> 6, fr = lane & 15, fq = lane >> 4;
    const int tt = u >> 4, hh = u & 15;
    const bf16_t* Z = (const bf16_t*)(p.ws + WS_Z); const bf16_t* OLAT = (const bf16_t*)(p.ws + WS_SC); const bf16_t* WuvT = (const bf16_t*)(p.ws + WS_WUV) + (size_t)hh * 128 * 256; bf16_t* MRG = (bf16_t*)(p.ws + WS_MRG);
    const size_t t = (size_t)tt * 128 + wave * 16 + fr;
    bf16x8 of[8];
#pragma unroll
    for (int s = 0; s < 8; ++s) of[s] = *(const bf16x8*)(OLAT + t * 4096 + hh * 256 + 32 * s + 8 * fq);
    for (int j = 0; j < 8; ++j) { f32x4 acc = {0.f, 0.f, 0.f, 0.f};
#pragma unroll
        for (int s = 0; s < 8; ++s) { const bf16x8 wf = *(const bf16x8*)(WuvT + (size_t)(16 * j + fr) * 256 + 32 * s + 8 * fq); acc = MFMA16(wf, of[s], acc); }
        const int col = hh * 128 + 16 * j + 4 * fq;
        const u32x2 gr = *(const u32x2*)(Z + t * NINP + ZGD + col); const u32x2 mr = *(const u32x2*)(MRG + t * DM + col);
        const float o0 = bf2f(mr.x & 0xffffu) + sigmoidf_(bf2f(gr.x & 0xffffu)) * acc[0], o1 = bf2f(mr.x >> 16) + sigmoidf_(bf2f(gr.x >> 16)) * acc[1];
        const float o2 = bf2f(mr.y & 0xffffu) + sigmoidf_(bf2f(gr.y & 0xffffu)) * acc[2], o3 = bf2f(mr.y >> 16) + sigmoidf_(bf2f(gr.y >> 16)) * acc[3];
        u32x2 o; o.x = pk2(o0, o1); o.y = pk2(o2, o3); *(u32x2*)(MRG + t * DM + col) = o; }
}

__device__ __forceinline__ void gemm_store(unsigned char* smem, const bf16_t* A, const bf16_t* Bt, int N, int K, bf16_t* O, int act) {
    pg8::Gemm g; g.A = A; g.Bt = Bt; g.M = NT; g.N = N; g.K = K;
    pg8::StaticOrder S; S.init(NT, N, (int)gridDim.x, (int)BIDX());
    if (act) { EpiStoreBf16<1> E; E.O = O; E.ldc = N; pg8::gemm_phase<EpiStoreBf16<1>, pg8::StaticOrder, false, false>((PG8_LAS unsigned char*)smem, g, S, E); }
    else { EpiStoreBf16<0> E; E.O = O; E.ldc = N; pg8::gemm_phase<EpiStoreBf16<0>, pg8::StaticOrder, false, false>((PG8_LAS unsigned char*)smem, g, S, E); }
}
__device__ __forceinline__ void gemm_resid(unsigned char* smem, const bf16_t* A, const bf16_t* Bt, int K, const float* base, float* out, const float* gate) {
    pg8::Gemm g; g.A = A; g.Bt = Bt; g.M = NT; g.N = DM; g.K = K;
    pg8::StaticOrder S; S.init(NT, DM, (int)gridDim.x, (int)BIDX());
    EpiResidual E; E.base = base; E.out = out; E.gate = gate;
    pg8::gemm_phase<EpiResidual, pg8::StaticOrder, false, false>((PG8_LAS unsigned char*)smem, g, S, E);
}

__global__ void __launch_bounds__(512) mega(Params p) {
    extern __shared__ __attribute__((aligned(16))) unsigned char smem[];
    cg::grid_group grid = cg::this_grid();
    const float* MOD = (const float*)(p.ws + WS_MOD);
    bf16_t* H = (bf16_t*)(p.ws + WS_H); bf16_t* Zb = (bf16_t*)(p.ws + WS_Z); bf16_t* MRG = (bf16_t*)(p.ws + WS_MRG); bf16_t* HID = (bf16_t*)(p.ws + WS_UT);
    const bf16_t* WinT = (const bf16_t*)(p.ws + WS_WIN); const bf16_t* WoutT = (const bf16_t*)(p.ws + WS_WOUT); const bf16_t* W1T = (const bf16_t*)(p.ws + WS_W1); const bf16_t* W2T = (const bf16_t*)(p.ws + WS_W2);
    for (int ph = p.ph_lo; ph < p.ph_hi; ++ph) {
        if (ph == 0) { phase_modp(p, smem); phase_convert(p, 0, smem); }
        else if (ph == 1) phase_modreduce(p);
        else if (ph == NPH - 1) phase_final(p.out, p.final_g, p.out);
        else {
            const int l = (ph - 2) / 10, s = (ph - 2) % 10; const float* mod = MOD + (size_t)l * 2 * NMOD;
            if (s == 0) { if (l == 1) phase_convert(p, 1, smem); phase_norm(l == 0 ? p.x : p.out, p.norm1_g + l * DM, mod + 0, mod + 2048, H); }
            else if (s == 1) gemm_store(smem, H, WinT, NINP, DM, Zb, 0);
            else if (s == 2) { for (int u = BIDX(); u < 512; u += gridDim.x) gla1_unit(p, l, u, smem); phase_kvnorm(p, l); for (int u = BIDX(); u < 1056; u += gridDim.x) score_unit(p, u); }
            else if (s == 3) { phase_gla_scan(p); phase_topk(p); }
            else if (s == 4) { for (int u = BIDX(); u < 512; u += gridDim.x) gla3_unit(p, l, u, smem); phase_attn(p, smem); }
            else if (s == 5) { for (int u = BIDX(); u < 1024; u += gridDim.x) upproj_unit(p, u); }
            else if (s == 6) gemm_resid(smem, MRG, WoutT, DM, l == 0 ? p.x : p.out, p.out, mod + 4096);
            else if (s == 7) phase_norm(p.out, p.norm2_g + l * DM, mod + 6144, mod + 8192, H);
            else if (s == 8) gemm_store(smem, H, W1T, DFF, DM, HID, 1);
            else gemm_resid(smem, HID, W2T, DFF, p.out, p.out, mod + 10240);
        }
        if (ph + 1 < p.ph_hi) grid.sync();
    }
}

extern "C" void kernel_launch(void* const* d_in, const int* in_sizes, int n_in, void* d_out, int out_size, void* d_ws, size_t ws_size, hipStream_t stream) {
    static int grid = 0;
    if (grid == 0) {
        if (n_in != 17 || out_size != NT * DM || ws_size < WS_END) { fprintf(stderr, "kernel_launch: unexpected shapes (n_in %d out %d ws %zu need %zu)\n", n_in, out_size, ws_size, (size_t)WS_END); grid = -1; return; }
        if (hipFuncSetAttribute((const void*)mega, hipFuncAttributeMaxDynamicSharedMemorySize, LDS_BYTES) != hipSuccess) { fprintf(stderr, "kernel_launch: hipFuncSetAttribute failed\n"); grid = -1; return; }
        int dev = 0, cus = 0, per_cu = 0;
        hipGetDevice(&dev); hipDeviceGetAttribute(&cus, hipDeviceAttributeMultiprocessorCount, dev);
        hipOccupancyMaxActiveBlocksPerMultiprocessor(&per_cu, (const void*)mega, 512, LDS_BYTES);
        if (per_cu < 1) { fprintf(stderr, "kernel_launch: occupancy query says %d blocks per CU\n", per_cu); }
        (void)hipGetLastError();
        grid = cus > 0 ? cus : 256;
    }
    if (grid < 0) return;
    Params p{};
    const float** pp = (const float**)&p;
    for (int i = 0; i < 17; ++i) pp[i] = (const float*)d_in[i];
    p.out = (float*)d_out; p.ws = (unsigned char*)d_ws;
#if MK_SINGLE
    p.ph_lo = 0; p.ph_hi = NPH;
    void* args[] = {&p};
    hipError_t e = hipLaunchCooperativeKernel((const void*)mega, dim3(grid), dim3(512), args, LDS_BYTES, stream);
    if (e != hipSuccess) fprintf(stderr, "cooperative launch failed: %s (grid %d)\n", hipGetErrorString(e), grid);
#else
    for (int ph = 0; ph < NPH; ++ph) { p.ph_lo = ph; p.ph_hi = ph + 1; hipLaunchKernelGGL(mega, dim3(grid), dim3(512), LDS_BYTES, stream, p); }
#endif
}
```

```cpp
#include <hip/hip_runtime.h>
#include <hip/hip_cooperative_groups.h>
#include <cstdio>
#include <cstdint>
namespace cg = cooperative_groups;
#ifndef MK_SINGLE
#define MK_SINGLE 1
#endif
__device__ __forceinline__ int TIDX() { int t = threadIdx.x; asm volatile("" : "+v"(t)); return t; }
__device__ __forceinline__ int BIDX() { int t = blockIdx.x; asm volatile("" : "+s"(t)); return t; }
namespace pg8 {
#define PG8_LAS __attribute__((address_space(3)))
typedef unsigned short bf16_t;
typedef short bf16x8 __attribute__((ext_vector_type(8)));
typedef float f32x4 __attribute__((ext_vector_type(4)));
typedef unsigned u32x4 __attribute__((ext_vector_type(4)));
constexpr int BM = 256, BK = 64, HALF = 128, HTB = HALF * BK * 2  , STAGE_BYTES = 8 * HTB, NXCD = 8, WGM = 8;

__host__ __device__ __forceinline__ int lds_byte(int r, int c) { const int st = (r >> 4) * 2 + (c >> 5), rr = r & 15, cc = c & 31, ob = rr * 64 + cc * 2; return st * 1024 + (ob ^ (((ob >> 9) & 1) << 5)); }
__host__ __device__ __forceinline__ void stage_rc(int b, int& R, int& C) { const int st = b / 1024, sb = b % 1024, swz = sb ^ (((sb >> 9) & 1) << 5); R = (st >> 1) * 16 + swz / 64; C = (st & 1) * 32 + (swz % 64) / 2; }
__host__ __device__ __forceinline__ int perm32(int rho) { const int n = rho >> 4, i = rho & 15; return 8 * (i >> 2) + 4 * n + (i & 3); }

struct Unit { int pm, pn; };
struct Gemm { const bf16_t* A; const bf16_t* Bt; int M, N, K; };

struct StaticOrder {
    int nM, nN, nwg, G, c;
    __host__ __device__ void init(int M, int N, int G_, int c_) { nM = M / BM; nN = N / BM; nwg = nM * nN; G = G_; c = c_; }
    __host__ __device__ bool next(int i, Unit& u) const {
        const long L = (long)i * G + c; if (L >= nwg) return false;
        int wgid = (int)L; { const int q = nwg / NXCD, r = nwg % NXCD, xcd = wgid % NXCD, off = wgid / NXCD; wgid = (xcd < r ? xcd * (q + 1) : r * (q + 1) + (xcd - r) * q) + off; }
        const int nig = WGM * nN, gid = wgid / nig, fm = gid * WGM, gsz = (nM - fm) < WGM ? (nM - fm) : WGM;
        u.pm = fm + ((wgid % nig) % gsz); u.pn = (wgid % nig) / gsz; return true;
    }
    __device__ __forceinline__ void a_ready(const Unit&) const {}
    __device__ __forceinline__ void done(const Unit&) const {}
};

__device__ __forceinline__ unsigned cvt_pk_bf16(float lo, float hi) { unsigned r; asm volatile("v_cvt_pk_bf16_f32 %0, %1, %2" : "=v"(r) : "v"(lo), "v"(hi)); return r; }
template <class Epi, class Sched, bool ALIGN_EPI = false, bool SP2 = false>
__device__ __forceinline__ void gemm_phase(PG8_LAS unsigned char* lds, const Gemm g, const Sched& S, const Epi& E) {
    const int tid = TIDX(), wid = __builtin_amdgcn_readfirstlane(tid >> 6), lane = tid & 63, wr = wid >> 2, wc = wid & 3, fr = lane & 15, fq = lane >> 4;
    const int K = g.K, nt = K / BK;
    unsigned voffA[2], voffB[2];
#pragma unroll
    for (int i = 0; i < 2; ++i) { int R, C; stage_rc(tid * 16 + i * 8192, R, C); const int Rb = Epi::PERM ? ((R & ~31) + perm32(R & 31)) : R;
        voffA[i] = (unsigned)(R * K + C) * 2u; voffB[i] = (unsigned)(Rb * K + C) * 2u; }
    const size_t kstep = (size_t)(BK * 2);
    const size_t hstep = (size_t)HALF * K * 2;
    const size_t tstep = 2 * hstep;
    const unsigned ldsw = (unsigned)wid * 1024u;
    const int aoff = lds_byte(wr * 64 + fr, fq * 8), boff = lds_byte(wc * 32 + fr, fq * 8);
#define PG8_SA(b, h) (((b) * 2 + (h)) * HTB)
#define PG8_SB(b, h) ((4 + (b) * 2 + (h)) * HTB)
#define PG8_STAGE(bufoff, gbase, voff) do { _Pragma("unroll") for (int _i = 0; _i < 2; ++_i) \
        __builtin_amdgcn_global_load_lds((const unsigned*)((const char*)(gbase) + (voff)[_i]), (PG8_LAS unsigned*)(lds + (bufoff) + ldsw + _i * 8192), 16, 0, 0); } while (0)
#define PG8_LDA(dst, b, h) do { _Pragma("unroll") for (int m = 0; m < 4; ++m) _Pragma("unroll") for (int k = 0; k < 2; ++k) dst[m][k] = *(const PG8_LAS bf16x8*)(lds + PG8_SA(b, h) + aoff + m * 2048 + k * 1024); } while (0)
#define PG8_LDB(dst, b, h) do { _Pragma("unroll") for (int n = 0; n < 2; ++n) _Pragma("unroll") for (int k = 0; k < 2; ++k) dst[n][k] = *(const PG8_LAS bf16x8*)(lds + PG8_SB(b, h) + boff + n * 2048 + k * 1024); } while (0)
#define PG8_MMA(ai, bj, At, Bt) do { __builtin_amdgcn_s_setprio(1); _Pragma("unroll") for (int m = 0; m < 4; ++m) _Pragma("unroll") for (int n = 0; n < 2; ++n) _Pragma("unroll") for (int k = 0; k < 2; ++k) \
        acc[ai][bj][m][n] = __builtin_amdgcn_mfma_f32_16x16x32_bf16(Bt[n][k], At[m][k], acc[ai][bj][m][n], 0, 0, 0); __builtin_amdgcn_s_setprio(0); } while (0)
#define PG8_WAIT_V(n) asm volatile("s_waitcnt vmcnt(" #n ")" ::: "memory")
#define PG8_WAIT_L(n) asm volatile("s_waitcnt lgkmcnt(" #n ")" ::: "memory")
#define PG8_BAR __builtin_amdgcn_s_barrier()
#define PG8_SCHED __builtin_amdgcn_sched_barrier(0)
    Unit cur, nxt; int ui = 0;
    if (!S.next(0, cur)) return;
    f32x4 acc[2][2][4][2];
#pragma unroll
    for (int a = 0; a < 2; ++a)
#pragma unroll
        for (int b = 0; b < 2; ++b)
#pragma unroll
            for (int m = 0; m < 4; ++m)
#pragma unroll
                for (int n = 0; n < 2; ++n) acc[a][b][m][n] = (f32x4){0.f, 0.f, 0.f, 0.f};
    bf16x8 At[4][2], B0[2][2], B1[2][2];
    const char* cA = (const char*)g.A + (size_t)cur.pm * tstep; const char* cB = (const char*)g.Bt + (size_t)cur.pn * tstep;
    S.a_ready(cur);
    if constexpr (SP2) {
        PG8_STAGE(PG8_SB(0, 0), cB, voffB); PG8_STAGE(PG8_SB(0, 1), cB + hstep, voffB); PG8_STAGE(PG8_SA(0, 0), cA, voffA); PG8_STAGE(PG8_SA(0, 1), cA + hstep, voffA);
        if (wr == 1) PG8_BAR;
        PG8_WAIT_V(2); PG8_BAR;
        PG8_STAGE(PG8_SB(1, 0), cB + kstep, voffB); PG8_STAGE(PG8_SA(1, 0), cA + kstep, voffA); PG8_STAGE(PG8_SB(1, 1), cB + hstep + kstep, voffB);
        PG8_WAIT_V(6); PG8_BAR;
    } else {
        PG8_STAGE(PG8_SB(0, 0), cB, voffB); PG8_STAGE(PG8_SA(0, 0), cA, voffA); PG8_STAGE(PG8_SB(0, 1), cB + hstep, voffB); PG8_STAGE(PG8_SA(0, 1), cA + hstep, voffA);
        if (wr == 1) PG8_BAR;
        PG8_WAIT_V(4); PG8_BAR;
        PG8_STAGE(PG8_SB(1, 0), cB + kstep, voffB); PG8_STAGE(PG8_SA(1, 0), cA + kstep, voffA); PG8_STAGE(PG8_SB(1, 1), cB + hstep + kstep, voffB);
        PG8_WAIT_V(6); PG8_BAR;
    }
    for (;;) {
        const bool has_next = S.next(ui + 1, nxt);
        const char* nA = has_next ? (const char*)g.A + (size_t)nxt.pm * tstep : cA; const char* nB = has_next ? (const char*)g.Bt + (size_t)nxt.pn * tstep : cB;
        for (int t = 0; t < nt; t += 2) {
            const bool last = (t == nt - 2);
            const char* a1 = cA + (size_t)(t + 1) * kstep;
            const char* a2 = last ? nA : cA + (size_t)(t + 2) * kstep; const char* b2 = last ? nB : cB + (size_t)(t + 2) * kstep;
            const char* a3 = a2 + kstep; const char* b3 = b2 + kstep;
            if (last && has_next) S.a_ready(nxt);
            if constexpr (SP2) {
            PG8_LDB(B0, 0, 0); PG8_LDB(B1, 0, 1); PG8_SCHED; PG8_LDA(At, 0, 0); PG8_STAGE(PG8_SA(1, 1), a1 + hstep, voffA);
            PG8_WAIT_V(8); PG8_WAIT_L(0); PG8_BAR; PG8_MMA(0, 0, At, B0); PG8_MMA(0, 1, At, B1); PG8_BAR; PG8_SCHED;
            PG8_LDA(At, 0, 1); PG8_STAGE(PG8_SB(0, 0), b2, voffB); PG8_STAGE(PG8_SB(0, 1), b2 + hstep, voffB); PG8_STAGE(PG8_SA(0, 0), a2, voffA);
            PG8_WAIT_V(8); PG8_WAIT_L(0); PG8_BAR; PG8_MMA(1, 0, At, B0); PG8_MMA(1, 1, At, B1); PG8_BAR; PG8_SCHED;
            PG8_LDB(B0, 1, 0); PG8_LDB(B1, 1, 1); PG8_SCHED; PG8_LDA(At, 1, 0); PG8_STAGE(PG8_SA(0, 1), a2 + hstep, voffA);
            PG8_WAIT_V(8); PG8_WAIT_L(0); PG8_BAR; PG8_MMA(0, 0, At, B0); PG8_MMA(0, 1, At, B1); PG8_BAR; PG8_SCHED;
            PG8_LDA(At, 1, 1); PG8_STAGE(PG8_SB(1, 0), b3, voffB); PG8_STAGE(PG8_SB(1, 1), b3 + hstep, voffB); PG8_STAGE(PG8_SA(1, 0), a3, voffA);
            PG8_WAIT_V(8); PG8_WAIT_L(0); PG8_BAR; PG8_MMA(1, 0, At, B0); PG8_MMA(1, 1, At, B1); PG8_BAR; PG8_SCHED;
            } else {
            PG8_LDB(B0, 0, 0); PG8_SCHED; PG8_LDA(At, 0, 0); PG8_STAGE(PG8_SA(1, 1), a1 + hstep, voffA);
            PG8_WAIT_L(8); PG8_BAR; PG8_WAIT_L(0); PG8_MMA(0, 0, At, B0); PG8_BAR; PG8_SCHED;
            PG8_LDB(B1, 0, 1); PG8_STAGE(PG8_SB(0, 0), b2, voffB);
            PG8_BAR; PG8_WAIT_L(0); PG8_MMA(0, 1, At, B1); PG8_BAR;
            PG8_LDA(At, 0, 1); PG8_STAGE(PG8_SA(0, 0), a2, voffA);
            PG8_BAR; PG8_WAIT_L(0); PG8_MMA(1, 0, At, B0); PG8_BAR; PG8_SCHED;
            PG8_STAGE(PG8_SB(0, 1), b2 + hstep, voffB);
            PG8_WAIT_V(6); PG8_BAR; PG8_MMA(1, 1, At, B1); PG8_BAR;
            PG8_LDB(B0, 1, 0); PG8_SCHED; PG8_LDA(At, 1, 0); PG8_STAGE(PG8_SA(0, 1), a2 + hstep, voffA);
            PG8_WAIT_L(8); PG8_BAR; PG8_WAIT_L(0); PG8_MMA(0, 0, At, B0); PG8_BAR; PG8_SCHED;
            PG8_LDB(B1, 1, 1); PG8_STAGE(PG8_SB(1, 0), b3, voffB);
            PG8_BAR; PG8_WAIT_L(0); PG8_MMA(0, 1, At, B1); PG8_BAR;
            PG8_LDA(At, 1, 1); PG8_STAGE(PG8_SA(1, 0), a3, voffA);
            PG8_BAR; PG8_WAIT_L(0); PG8_MMA(1, 0, At, B0); PG8_BAR; PG8_SCHED;
            PG8_STAGE(PG8_SB(1, 1), b3 + hstep, voffB);
            PG8_WAIT_V(6); PG8_BAR; PG8_MMA(1, 1, At, B1); PG8_BAR;
            }
        }
        if constexpr (ALIGN_EPI) { if (wr == 0) PG8_BAR; }
        if constexpr (!Epi::AFTER_DRAIN) { E(acc, cur, wr, wc, fr, fq); S.done(cur); }
        if (!has_next) break;
#pragma unroll
        for (int a = 0; a < 2; ++a)
#pragma unroll
            for (int b = 0; b < 2; ++b)
#pragma unroll
                for (int m = 0; m < 4; ++m)
#pragma unroll
                    for (int n = 0; n < 2; ++n) acc[a][b][m][n] = (f32x4){0.f, 0.f, 0.f, 0.f};
        cur = nxt; cA = nA; cB = nB; ++ui;
        if constexpr (ALIGN_EPI) { if (wr == 1) PG8_BAR; }
    }
    PG8_WAIT_V(0);
    if constexpr (!ALIGN_EPI) { if (wr == 0) PG8_BAR; }
    PG8_BAR;
    if constexpr (Epi::AFTER_DRAIN) { E.fused(acc, cur, wr, wc, fr, fq, lds, wid, lane); S.done(cur); }
#undef PG8_SA
#undef PG8_SB
#undef PG8_STAGE
#undef PG8_LDA
#undef PG8_LDB
#undef PG8_MMA
#undef PG8_WAIT_V
#undef PG8_WAIT_L
#undef PG8_BAR
#undef PG8_SCHED
}
}

using pg8::bf16_t; using pg8::bf16x8; using pg8::f32x4; using pg8::u32x4;
typedef unsigned u32x2 __attribute__((ext_vector_type(2)));
typedef short s16x4 __attribute__((ext_vector_type(4)));
#define LAS __attribute__((address_space(3)))

constexpr int DM = 2048, SEQ = 4096, NT = 8192, NINP = 15872, NIN = 15712, DFF = 8192, NMOD = 12288;
constexpr int ZQ = 0, ZK = 1024, ZV = 2048, ZA = 4096, ZR = 4112, ZQL = 6160, ZKV = 10256, ZIQ = 10512, ZIK = 11536, ZIW = 11600, ZGG = 11616, ZGD = 13664;
constexpr float EPS = 1e-6f;
constexpr int LDS_BYTES = 147456;
constexpr int NPH = 23;

constexpr size_t WS_WIN = 0;
constexpr size_t WS_WOUT = WS_WIN + (size_t)NINP * DM * 2;
constexpr size_t WS_W1 = WS_WOUT + (size_t)DM * DM * 2;
constexpr size_t WS_W2 = WS_W1 + (size_t)DFF * DM * 2;
constexpr size_t WS_WUV = WS_W2 + (size_t)DFF * DM * 2;
constexpr size_t WS_MODP = WS_WUV + (size_t)16 * 128 * 256 * 2;
constexpr size_t WS_MOD = WS_MODP + (size_t)2 * 64 * 2 * NMOD * 4;
constexpr size_t WS_H = WS_MOD + (size_t)2 * 2 * NMOD * 4;
constexpr size_t WS_Z = WS_H + (size_t)NT * DM * 2;
constexpr size_t WS_QT = WS_Z + (size_t)NT * NINP * 2;
constexpr size_t WS_AM = WS_QT + (size_t)NT * 1024 * 2;
constexpr size_t WS_VT = WS_AM + (size_t)512 * 64 * 64 * 2;
constexpr size_t WS_DEC = WS_VT + (size_t)512 * 512 * 64 * 2;
constexpr size_t WS_UT = WS_DEC + (size_t)512 * 256 * 4;
constexpr size_t WS_KVN = WS_UT + (size_t)512 * 512 * 256 * 2;
constexpr size_t WS_SC = WS_KVN + (size_t)NT * 256 * 2;
constexpr size_t WS_IDX = WS_SC + (size_t)NT * 4096 * 4;
constexpr size_t WS_MRG = WS_IDX + (size_t)NT * 256 * 4;
constexpr size_t WS_END = WS_MRG + (size_t)NT * DM * 2;

struct Params {
    const float *x, *c, *w_mod, *b_mod, *norm1_g, *w_in, *w_gate_up, *b_gate, *gla_norm_g, *kv_norm_g, *w_uv, *w_out, *norm2_g, *w_ff1, *w_ff2, *rel_bias, *final_g;
    float* out; unsigned char* ws; int ph_lo, ph_hi;
};

__device__ __forceinline__ unsigned f2bf(float f) { unsigned u = __builtin_bit_cast(unsigned, f); return (u + 0x7fffu + ((u >> 16) & 1u)) >> 16; }
__device__ __forceinline__ unsigned pk2(float lo, float hi) { return f2bf(lo) | (f2bf(hi) << 16); }
__device__ __forceinline__ float bf2f(unsigned v) { return __builtin_bit_cast(float, v << 16); }
__device__ __forceinline__ float wave_sum(float v) {
#pragma unroll
    for (int o = 1; o < 64; o <<= 1) v += __shfl_xor(v, o);
    return v;
}
#define LDS_WAIT() asm volatile("s_waitcnt lgkmcnt(0)" ::: "memory")
__device__ __forceinline__ float sigmoidf_(float x) { return 1.f / (1.f + __expf(-x)); }
__device__ __forceinline__ float logsig(float x) { return fminf(x, 0.f) - log1pf(expf(-fabsf(x))); }

template <int ACT> struct EpiStoreBf16 {
    static constexpr bool PERM = true, AFTER_DRAIN = false;
    bf16_t* O; int ldc;
    __device__ __forceinline__ void operator()(const f32x4 (&acc)[2][2][4][2], const pg8::Unit& u, int wr, int wc, int fr, int fq) const {
        const int row0 = u.pm * 256 + wr * 64 + fr, col0 = u.pn * 256 + wc * 32 + 8 * fq;
#pragma unroll
        for (int ai = 0; ai < 2; ++ai)
#pragma unroll
            for (int m = 0; m < 4; ++m) { bf16_t* rowp = O + (size_t)(row0 + ai * 128 + m * 16) * ldc + col0;
#pragma unroll
                for (int bj = 0; bj < 2; ++bj) { f32x4 v0 = acc[ai][bj][m][0], v1 = acc[ai][bj][m][1];
                    if (ACT == 1) {
#pragma unroll
                        for (int e = 0; e < 4; ++e) { float a = fmaxf(v0[e], 0.f), b = fmaxf(v1[e], 0.f); v0[e] = a * a; v1[e] = b * b; } }
                    u32x4 w; w.x = pk2(v0[0], v0[1]); w.y = pk2(v0[2], v0[3]); w.z = pk2(v1[0], v1[1]); w.w = pk2(v1[2], v1[3]);
                    *(u32x4*)(rowp + bj * 128) = w; } }
    }
};
struct EpiResidual {
    static constexpr bool PERM = false, AFTER_DRAIN = false;
    const float* base; float* out; const float* gate;
    __device__ __forceinline__ void operator()(const f32x4 (&acc)[2][2][4][2], const pg8::Unit& u, int wr, int wc, int fr, int fq) const {
        const int col0 = u.pn * 256 + wc * 32 + 4 * fq; const float* gb = gate + (size_t)((u.pm * 256) >> 12) * NMOD;
#pragma unroll
        for (int ai = 0; ai < 2; ++ai)
#pragma unroll
            for (int m = 0; m < 4; ++m) { const size_t off = (size_t)(u.pm * 256 + ai * 128 + wr * 64 + m * 16 + fr) * DM;
#pragma unroll
                for (int bj = 0; bj < 2; ++bj)
#pragma unroll
                    for (int n = 0; n < 2; ++n) { const int c = col0 + bj * 128 + n * 16; const f32x4 gv = *(const f32x4*)(gb + c), bs = *(const f32x4*)(base + off + c);
                        *(f32x4*)(out + off + c) = bs + gv * acc[ai][bj][m][n]; } }
    }
};

__device__ __forceinline__ void transpose_item(const float* __restrict__ W, int K, int N, bf16_t* __restrict__ WT, float* scr, int item, int lane) {
    const int nblk = N / 32, kb = item / nblk, nb = item % nblk, k0 = 64 * kb, n0 = 32 * nb;
#pragma unroll 8
    for (int i = 0; i < 32; ++i) { const int kk = 2 * i + (lane >> 5); scr[kk * 33 + (lane & 31)] = W[(size_t)(k0 + kk) * N + n0 + (lane & 31)]; }
    LDS_WAIT();
    const int c = lane & 7;
#pragma unroll
    for (int j = 0; j < 4; ++j) { const int n = (lane >> 3) + 8 * j; const float* s = scr + (8 * c) * 33 + n;
        u32x4 o; o.x = pk2(s[0 * 33], s[1 * 33]); o.y = pk2(s[2 * 33], s[3 * 33]); o.z = pk2(s[4 * 33], s[5 * 33]); o.w = pk2(s[6 * 33], s[7 * 33]);
        *(u32x4*)(WT + (size_t)(n0 + n) * K + k0 + 8 * c) = o; }
    LDS_WAIT();
}
__device__ __forceinline__ void phase_convert(const Params& p, int l, unsigned char* smem) {
    const int tid = TIDX(), lane = tid & 63, wave = tid >> 6;
    float* scr = (float*)(smem + 16384 + wave * 8448);
    const int gw = BIDX() * 8 + wave, NGW = gridDim.x * 8;
    bf16_t* WinT = (bf16_t*)(p.ws + WS_WIN); bf16_t* WoutT = (bf16_t*)(p.ws + WS_WOUT); bf16_t* W1T = (bf16_t*)(p.ws + WS_W1); bf16_t* W2T = (bf16_t*)(p.ws + WS_W2); bf16_t* WuvT = (bf16_t*)(p.ws + WS_WUV);
    constexpr int I_IN = 32 * (NIN / 32), I_OUT = 32 * 64, I_1 = 32 * 256, I_2 = 128 * 64, I_UV = 16 * 16;
    constexpr int NITEMS = I_IN + I_OUT + I_1 + I_2 + I_UV;
    for (int it = gw; it < NITEMS; it += NGW) {
        int r = it;
        if (r < I_IN) { transpose_item(p.w_in + (size_t)l * DM * NIN, DM, NIN, WinT, scr, r, lane); continue; } r -= I_IN;
        if (r < I_OUT) { transpose_item(p.w_out + (size_t)l * DM * DM, DM, DM, WoutT, scr, r, lane); continue; } r -= I_OUT;
        if (r < I_1) { transpose_item(p.w_ff1 + (size_t)l * DM * DFF, DM, DFF, W1T, scr, r, lane); continue; } r -= I_1;
        if (r < I_2) { transpose_item(p.w_ff2 + (size_t)l * DFF * DM, DFF, DM, W2T, scr, r, lane); continue; } r -= I_2;
        { const int hh = r >> 4, ri = r & 15; transpose_item(p.w_uv + ((size_t)l * 16 + hh) * 256 * 128, 256, 128, WuvT + (size_t)hh * 128 * 256, scr, ri, lane); }
    }
    const int gt = BIDX() * 512 + tid, NGT = gridDim.x * 512;
    for (int i = gt; i < (NINP - NIN) * DM / 8; i += NGT) *(u32x4*)(WinT + (size_t)NIN * DM + (size_t)i * 8) = (u32x4){0u, 0u, 0u, 0u};
}
__device__ __forceinline__ void phase_modp(const Params& p, unsigned char* smem) {
    const int tid = TIDX(), lane = tid & 63, wave = tid >> 6;
    float* ca = (float*)smem;
    for (int i = tid; i < 2 * DM; i += 512) { const float v = p.c[i]; ca[i] = v / (1.f + expf(-v)); }
    __syncthreads();
    float* MODP = (float*)(p.ws + WS_MODP);
    const int gw = BIDX() * 8 + wave, NGW = gridDim.x * 8;
    for (int u = gw; u < 2 * 48 * 64; u += NGW) {
        const int l = u / (48 * 64), r = u % (48 * 64), cgp = r >> 6, kc = r & 63;
        const float* W = p.w_mod + (size_t)l * DM * NMOD + (size_t)(kc * 32) * NMOD + cgp * 256 + lane * 4;
        f32x4 a0 = {0.f, 0.f, 0.f, 0.f}, a1 = {0.f, 0.f, 0.f, 0.f};
#pragma unroll 8
        for (int rr = 0; rr < 32; ++rr) { const f32x4 w = *(const f32x4*)(W + (size_t)rr * NMOD); const float c0 = ca[kc * 32 + rr], c1 = ca[DM + kc * 32 + rr]; a0 += c0 * w; a1 += c1 * w; }
        float* o = MODP + ((size_t)(l * 64 + kc) * 2) * NMOD + cgp * 256 + lane * 4;
        *(f32x4*)o = a0; *(f32x4*)(o + NMOD) = a1;
    }
}
__device__ __forceinline__ void phase_modreduce(const Params& p) {
    const int gt = BIDX() * 512 + TIDX();
    const float* MODP = (const float*)(p.ws + WS_MODP); float* MOD = (float*)(p.ws + WS_MOD);
    for (int i = gt; i < 2 * 2 * NMOD; i += gridDim.x * 512) {
        const int l = i / (2 * NMOD), b = (i / NMOD) & 1, j = i % NMOD;
        float s = p.b_mod[l * NMOD + j];
        for (int kc = 0; kc < 64; ++kc) s += MODP[((size_t)(l * 64 + kc) * 2 + b) * NMOD + j];
        MOD[i] = s;
    }
}

__device__ __forceinline__ void phase_norm(const float* X, const float* g, const float* sh, const float* sc, bf16_t* H) {
    const int lane = TIDX() & 63, wave = TIDX() >> 6;
    const int NGW = gridDim.x * 8;
    for (int row = BIDX() * 8 + wave; row < NT; row += 2 * NGW) {
        const int row2 = row + NGW < NT ? row + NGW : row;
        f32x4 v[2][8]; float ss[2] = {0.f, 0.f};
#pragma unroll
        for (int q = 0; q < 2; ++q) { const float* xr = X + (size_t)(q ? row2 : row) * DM + lane * 4;
#pragma unroll
            for (int j = 0; j < 8; ++j) v[q][j] = *(const f32x4*)(xr + j * 256); }
#pragma unroll
        for (int q = 0; q < 2; ++q)
#pragma unroll
            for (int j = 0; j < 8; ++j) ss[q] += (v[q][j][0] * v[q][j][0] + v[q][j][1] * v[q][j][1]) + (v[q][j][2] * v[q][j][2] + v[q][j][3] * v[q][j][3]);
#pragma unroll
        for (int q = 0; q < 2; ++q) { const int rr = q ? row2 : row; const int b = rr >> 12; const float rstd = rsqrtf(wave_sum(ss[q]) * (1.f / DM) + EPS);
#pragma unroll
            for (int j = 0; j < 8; ++j) { const int c = j * 256 + lane * 4; const f32x4 gv = *(const f32x4*)(g + c), sv = *(const f32x4*)(sc + (size_t)b * NMOD + c), hv = *(const f32x4*)(sh + (size_t)b * NMOD + c);
                const f32x4 o = (v[q][j] * rstd * gv) * (1.f + sv) + hv; u32x2 w; w.x = pk2(o[0], o[1]); w.y = pk2(o[2], o[3]);
                *(u32x2*)(H + (size_t)rr * DM + c) = w; } }
    }
}
__device__ __forceinline__ void phase_final(const float* X, const float* g, float* out) {
    const int lane = TIDX() & 63, wave = TIDX() >> 6;
    for (int row = BIDX() * 8 + wave; row < NT; row += gridDim.x * 8) {
        const float* xr = X + (size_t)row * DM + lane * 4;
        f32x4 v[8]; float ss = 0.f;
#pragma unroll
        for (int j = 0; j < 8; ++j) { v[j] = *(const f32x4*)(xr + j * 256); ss += (v[j][0] * v[j][0] + v[j][1] * v[j][1]) + (v[j][2] * v[j][2] + v[j][3] * v[j][3]); }
        const float rstd = rsqrtf(wave_sum(ss) * (1.f / DM) + EPS);
#pragma unroll
        for (int j = 0; j < 8; ++j) { const int c = j * 256 + lane * 4; const f32x4 gv = *(const f32x4*)(g + c); *(f32x4*)(out + (size_t)row * DM + c) = v[j] * rstd * gv; }
    }
}

#define MFMA16(a, b, c) __builtin_amdgcn_mfma_f32_16x16x32_bf16((a), (b), (c), 0, 0, 0)
__device__ __forceinline__ float logsig_fast(float x) { return fminf(x, 0.f) - __logf(1.f + __expf(-fabsf(x))); }
__device__ __forceinline__ void gla1_unit(const Params& p, int l, int u, unsigned char* smem) {
    const int tid = TIDX(), lane = tid & 63, wave = tid >> 6, fr = lane & 15, fq = lane >> 4;
    const int b = u >> 8, c = (u >> 2) & 63, h = u & 3, t0 = b * SEQ + c * 64;
    const bf16_t* Z = (const bf16_t*)(p.ws + WS_Z);
    float* AL = (float*)smem;
    float* TOT = (float*)(smem + 4096);
    bf16_t* KST = (bf16_t*)(smem + 6144);
    bf16_t* QS = (bf16_t*)(smem + 43008);
    bf16_t* KI = (bf16_t*)(smem + 76800);
    bf16_t* VT = (bf16_t*)(smem + 43008);
    bf16_t* QT = (bf16_t*)(p.ws + WS_QT) + ((size_t)(b * 4 + h) * SEQ + c * 64) * 256; bf16_t* AM = (bf16_t*)(p.ws + WS_AM); bf16_t* VTG = (bf16_t*)(p.ws + WS_VT) + (size_t)u * 32768; float* DEC = (float*)(p.ws + WS_DEC); bf16_t* UT = (bf16_t*)(p.ws + WS_UT);
    for (int i = tid; i < 1024; i += 512) AL[i] = bf2f(Z[(size_t)(t0 + (i >> 4)) * NINP + ZA + (i & 15)]);
#pragma unroll
    for (int k = 0; k < 4; ++k) { const int i = tid + 512 * k, row = i >> 5, ch = i & 31; const bf16_t* zr = Z + (size_t)(t0 + row) * NINP + h * 256 + ch * 8;
        *(u32x4*)(QS + row * 264 + ch * 8) = *(const u32x4*)(zr + ZQ); *(u32x4*)(KI + row * 264 + ch * 8) = *(const u32x4*)(zr + ZK); }
    const int d = tid & 255, half = tid >> 8;
    float w[16];
#pragma unroll
    for (int r = 0; r < 16; ++r) w[r] = p.w_gate_up[((size_t)l * 16 + r) * 1024 + h * 256 + d];
    const float bias = p.b_gate[l * 1024 + h * 256 + d];
    __syncthreads();
    float g[32];
    {   float sum = 0.f;
#pragma unroll
        for (int pl = 0; pl < 32; ++pl) { const int pos = half * 32 + pl; float x = bias;
#pragma unroll
            for (int r = 0; r < 16; ++r) x += AL[pos * 16 + r] * w[r];
            g[pl] = logsig_fast(x) * (1.f / 16.f); sum += g[pl]; }
        TOT[half * 256 + d] = sum; }
    __syncthreads();
    {   const float blast = TOT[d] + TOT[256 + d], eb = __expf(blast); float run = half ? TOT[d] : 0.f;
#pragma unroll
        for (int p8 = 0; p8 < 4; ++p8) { unsigned ks[8];
#pragma unroll
            for (int e = 0; e < 8; ++e) { const int pl = p8 * 8 + e, pos = half * 32 + pl;
                run += g[pl];
                const float er = __expf(run), ier = __builtin_amdgcn_rcpf(er);
                const float qv = bf2f(QS[pos * 264 + d]), kv = bf2f(KI[pos * 264 + d]);
                QS[pos * 264 + d] = (bf16_t)f2bf(qv * 0.0625f * er);
                KI[pos * 264 + d] = (bf16_t)f2bf(kv * ier);
                ks[e] = f2bf(kv * (eb * ier)); }
            u32x4 o; o.x = ks[0] | (ks[1] << 16); o.y = ks[2] | (ks[3] << 16); o.z = ks[4] | (ks[5] << 16); o.w = ks[6] | (ks[7] << 16);
            *(u32x4*)(KST + d * 72 + half * 32 + p8 * 8) = o; }
        if (half == 0) DEC[u * 256 + d] = eb; }
    __syncthreads();
#pragma unroll
    for (int k = 0; k < 4; ++k) { const int i = tid + 512 * k, row = i >> 5, ch = i & 31; *(u32x4*)(QT + row * 256 + ch * 8) = *(const u32x4*)(QS + row * 264 + ch * 8); }
#pragma unroll
    for (int tt = 0; tt < 2; ++tt) { const int id = wave * 2 + tt, it = id >> 2, jt = id & 3; f32x4 acc = {0.f, 0.f, 0.f, 0.f};
        if (jt <= it) {
#pragma unroll
            for (int s = 0; s < 8; ++s) { const bf16x8 a = *(const bf16x8*)(QS + (it * 16 + fr) * 264 + 32 * s + 8 * fq), bb = *(const bf16x8*)(KI + (jt * 16 + fr) * 264 + 32 * s + 8 * fq);
                acc = MFMA16(a, bb, acc); } }
#pragma unroll
        for (int r = 0; r < 4; ++r) { const int i = it * 16 + 4 * fq + r, j = jt * 16 + fr; AM[(size_t)u * 4096 + i * 64 + j] = (bf16_t)f2bf(j <= i ? acc[r] : 0.f); } }
    __syncthreads();
    {   u32x4 vr[8];
#pragma unroll
        for (int it = 0; it < 8; ++it) vr[it] = *(const u32x4*)(Z + (size_t)(t0 + lane) * NINP + ZV + h * 512 + (wave * 8 + it) * 8);
#pragma unroll
        for (int it = 0; it < 8; ++it) { const int dv0 = (wave * 8 + it) * 8;
#pragma unroll
            for (int e = 0; e < 4; ++e) { VT[(dv0 + 2 * e) * 72 + lane] = (bf16_t)(vr[it][e] & 0xffffu); VT[(dv0 + 2 * e + 1) * 72 + lane] = (bf16_t)(vr[it][e] >> 16); } } }
    __syncthreads();
#pragma unroll
    for (int k = 0; k < 8; ++k) { const int i = tid + 512 * k, dv = i >> 3, pc = i & 7; *(u32x4*)(VTG + dv * 64 + pc * 8) = *(const u32x4*)(VT + dv * 72 + pc * 8); }
    {   bf16x8 bfr[4][2];
#pragma unroll
        for (int nt = 0; nt < 4; ++nt)
#pragma unroll
            for (int s = 0; s < 2; ++s) bfr[nt][s] = *(const bf16x8*)(VT + (wave * 64 + nt * 16 + fr) * 72 + 32 * s + 8 * fq);
#pragma unroll 4
        for (int mt = 0; mt < 16; ++mt) { const bf16x8 a0 = *(const bf16x8*)(KST + (mt * 16 + fr) * 72 + 8 * fq), a1 = *(const bf16x8*)(KST + (mt * 16 + fr) * 72 + 32 + 8 * fq);
#pragma unroll
            for (int nt = 0; nt < 4; ++nt) { f32x4 acc = {0.f, 0.f, 0.f, 0.f}; acc = MFMA16(a0, bfr[nt][0], acc); acc = MFMA16(a1, bfr[nt][1], acc);
                u32x2 o; o.x = pk2(acc[0], acc[1]); o.y = pk2(acc[2], acc[3]);
                *(u32x2*)(UT + (size_t)u * 131072 + (size_t)(wave * 64 + nt * 16 + fr) * 256 + mt * 16 + 4 * fq) = o; } } }
    __syncthreads();
}

__device__ __forceinline__ void phase_gla_scan(const Params& p) {
    bf16_t* UT = (bf16_t*)(p.ws + WS_UT); const float* DEC = (const float*)(p.ws + WS_DEC);
    for (int gid = BIDX() * 512 + TIDX(); gid < 131072; gid += gridDim.x * 512) {
        const int bh = gid >> 14, b = bh >> 2, h = bh & 3, e = (gid & 16383) * 8, d0 = e & 255;
        float s[8];
#pragma unroll
        for (int i = 0; i < 8; ++i) s[i] = 0.f;
        for (int c4 = 0; c4 < 64; c4 += 4) { u32x4 uu[4]; f32x4 da[4], db[4];
#pragma unroll
            for (int k = 0; k < 4; ++k) { const int u = (b * 64 + c4 + k) * 4 + h; uu[k] = *(const u32x4*)(UT + (size_t)u * 131072 + e); da[k] = *(const f32x4*)(DEC + u * 256 + d0); db[k] = *(const f32x4*)(DEC + u * 256 + d0 + 4); }
#pragma unroll
            for (int k = 0; k < 4; ++k) { const int u = (b * 64 + c4 + k) * 4 + h;
                u32x4 o; o.x = pk2(s[0], s[1]); o.y = pk2(s[2], s[3]); o.z = pk2(s[4], s[5]); o.w = pk2(s[6], s[7]);
                *(u32x4*)(UT + (size_t)u * 131072 + e) = o;
                s[0] = da[k][0] * s[0] + bf2f(uu[k][0] & 0xffffu); s[1] = da[k][1] * s[1] + bf2f(uu[k][0] >> 16);
                s[2] = da[k][2] * s[2] + bf2f(uu[k][1] & 0xffffu); s[3] = da[k][3] * s[3] + bf2f(uu[k][1] >> 16);
                s[4] = db[k][0] * s[4] + bf2f(uu[k][2] & 0xffffu); s[5] = db[k][1] * s[5] + bf2f(uu[k][2] >> 16);
                s[6] = db[k][2] * s[6] + bf2f(uu[k][3] & 0xffffu); s[7] = db[k][3] * s[7] + bf2f(uu[k][3] >> 16); } }
    }
}

__device__ __forceinline__ void gla3_unit(const Params& p, int l, int u, unsigned char* smem) {
    const int tid = TIDX(), lane = tid & 63, wave = tid >> 6, fr = lane & 15, fq = lane >> 4;
    const int b = u >> 8, c = (u >> 2) & 63, h = u & 3, t0 = b * SEQ + c * 64;
    const bf16_t* Z = (const bf16_t*)(p.ws + WS_Z);
    bf16_t* QS = (bf16_t*)smem;
    bf16_t* AS = (bf16_t*)(smem + 33792);
    float* RED = (float*)(smem + 43008);
    float* RSTD = (float*)(smem + 45056);
    const bf16_t* QT = (const bf16_t*)(p.ws + WS_QT) + ((size_t)(b * 4 + h) * SEQ + c * 64) * 256; const bf16_t* AM = (const bf16_t*)(p.ws + WS_AM) + (size_t)u * 4096;
    const bf16_t* VTG = (const bf16_t*)(p.ws + WS_VT) + (size_t)u * 32768; const bf16_t* ST = (const bf16_t*)(p.ws + WS_UT) + (size_t)u * 131072; bf16_t* MRG = (bf16_t*)(p.ws + WS_MRG);
#pragma unroll
    for (int k = 0; k < 4; ++k) { const int i = tid + 512 * k, row = i >> 5, ch = i & 31; *(u32x4*)(QS + row * 264 + ch * 8) = *(const u32x4*)(QT + row * 256 + ch * 8); }
    { const int row = tid >> 3, ch = tid & 7; *(u32x4*)(AS + row * 72 + ch * 8) = *(const u32x4*)(AM + row * 64 + ch * 8); }
    __syncthreads();
    const int dv0 = wave * 64;
    f32x4 acc[4][4];
#pragma unroll
    for (int mt = 0; mt < 4; ++mt)
#pragma unroll
        for (int nt = 0; nt < 4; ++nt) acc[mt][nt] = (f32x4){0.f, 0.f, 0.f, 0.f};
#pragma unroll
    for (int s = 0; s < 8; ++s) { bf16x8 a[4], bb[4];
#pragma unroll
        for (int mt = 0; mt < 4; ++mt) a[mt] = *(const bf16x8*)(QS + (mt * 16 + fr) * 264 + 32 * s + 8 * fq);
#pragma unroll
        for (int nt = 0; nt < 4; ++nt) bb[nt] = *(const bf16x8*)(ST + (size_t)(dv0 + nt * 16 + fr) * 256 + 32 * s + 8 * fq);
#pragma unroll
        for (int mt = 0; mt < 4; ++mt)
#pragma unroll
            for (int nt = 0; nt < 4; ++nt) acc[mt][nt] = MFMA16(a[mt], bb[nt], acc[mt][nt]); }
#pragma unroll
    for (int s = 0; s < 2; ++s) { bf16x8 a[4], bb[4];
#pragma unroll
        for (int mt = 0; mt < 4; ++mt) a[mt] = *(const bf16x8*)(AS + (mt * 16 + fr) * 72 + 32 * s + 8 * fq);
#pragma unroll
        for (int nt = 0; nt < 4; ++nt) bb[nt] = *(const bf16x8*)(VTG + (dv0 + nt * 16 + fr) * 64 + 32 * s + 8 * fq);
#pragma unroll
        for (int mt = 0; mt < 4; ++mt)
#pragma unroll
            for (int nt = 0; nt < 4; ++nt) acc[mt][nt] = MFMA16(a[mt], bb[nt], acc[mt][nt]); }
#pragma unroll
    for (int mt = 0; mt < 4; ++mt)
#pragma unroll
        for (int r = 0; r < 4; ++r) { float ss = 0.f;
#pragma unroll
            for (int nt = 0; nt < 4; ++nt) ss += acc[mt][nt][r] * acc[mt][nt][r];
            ss += __shfl_xor(ss, 1); ss += __shfl_xor(ss, 2); ss += __shfl_xor(ss, 4); ss += __shfl_xor(ss, 8);
            if (fr == 0) RED[wave * 64 + mt * 16 + 4 * fq + r] = ss; }
    __syncthreads();
    if (tid < 64) { float t = 0.f;
#pragma unroll
        for (int w8 = 0; w8 < 8; ++w8) t += RED[w8 * 64 + tid];
        RSTD[tid] = rsqrtf(t * (1.f / 512.f) + EPS); }
    __syncthreads();
    const float* gn = p.gla_norm_g + l * 512;
#pragma unroll
    for (int mt = 0; mt < 4; ++mt)
#pragma unroll
        for (int r = 0; r < 4; ++r) { const int i = mt * 16 + 4 * fq + r; const float rs = RSTD[i]; const size_t t = (size_t)(t0 + i);
#pragma unroll
            for (int nt = 0; nt < 4; ++nt) { const int dv = dv0 + nt * 16 + fr, col = h * 512 + dv;
                const float rv = bf2f(Z[t * NINP + ZR + col]), gv = bf2f(Z[t * NINP + ZGG + col]);
                acc[mt][nt][r] = acc[mt][nt][r] * rs * gn[dv] * (rv * sigmoidf_(rv)) * sigmoidf_(gv); } }
#pragma unroll
    for (int mt = 0; mt < 4; ++mt)
#pragma unroll
        for (int r = 0; r < 4; ++r) { const size_t t = (size_t)(t0 + mt * 16 + 4 * fq + r);
#pragma unroll
            for (int nt = 0; nt < 4; ++nt) MRG[t * DM + h * 512 + dv0 + nt * 16 + fr] = (bf16_t)f2bf(acc[mt][nt][r]); }
    __syncthreads();
}

__device__ __forceinline__ void phase_kvnorm(const Params& p, int l) {
    const int lane = TIDX() & 63, wave = TIDX() >> 6;
    const bf16_t* Z = (const bf16_t*)(p.ws + WS_Z); bf16_t* KVN = (bf16_t*)(p.ws + WS_KVN);
    const f32x4 gv = *(const f32x4*)(p.kv_norm_g + l * 256 + lane * 4);
    for (int row = BIDX() * 8 + wave; row < NT; row += gridDim.x * 8) {
        const u32x2 raw = *(const u32x2*)(Z + (size_t)row * NINP + ZKV + lane * 4);
        const float v0 = bf2f(raw.x & 0xffffu), v1 = bf2f(raw.x >> 16), v2 = bf2f(raw.y & 0xffffu), v3 = bf2f(raw.y >> 16);
        const float rstd = rsqrtf(wave_sum((v0 * v0 + v1 * v1) + (v2 * v2 + v3 * v3)) * (1.f / 256.f) + EPS);
        u32x2 o; o.x = pk2(v0 * rstd * gv[0], v1 * rstd * gv[1]); o.y = pk2(v2 * rstd * gv[2], v3 * rstd * gv[3]);
        *(u32x2*)(KVN + (size_t)row * 256 + lane * 4) = o;
    }
}
__device__ __forceinline__ void score_unit(const Params& p, int u) {
    const int lane = TIDX() & 63, wave = TIDX() >> 6, fr = lane & 15, fq = lane >> 4;
    const int b = u / 528, i = u % 528; int qt = 0; while ((qt + 1) * (qt + 2) / 2 <= i) ++qt; const int kt = i - qt * (qt + 1) / 2;
    const bf16_t* Z = (const bf16_t*)(p.ws + WS_Z); float* SC = (float*)(p.ws + WS_SC);
    const size_t tq = (size_t)b * SEQ + qt * 128 + wave * 16 + fr, tk0 = (size_t)b * SEQ + kt * 128;
    bf16x8 ak[8][2];
#pragma unroll
    for (int m = 0; m < 8; ++m)
#pragma unroll
        for (int s = 0; s < 2; ++s) ak[m][s] = *(const bf16x8*)(Z + (tk0 + m * 16 + fr) * NINP + ZIK + 32 * s + 8 * fq);
    f32x4 sc[8];
#pragma unroll
    for (int m = 0; m < 8; ++m) sc[m] = (f32x4){0.f, 0.f, 0.f, 0.f};
    const bf16_t* zq = Z + tq * NINP + ZIQ + 8 * fq; const bf16_t* zw = Z + tq * NINP + ZIW;
    bf16x8 nb0 = *(const bf16x8*)(zq), nb1 = *(const bf16x8*)(zq + 32); unsigned nw = zw[0];
#pragma unroll 1
    for (int hh = 0; hh < 16; ++hh) {
        const bf16x8 b0 = nb0, b1 = nb1; const float wgt = bf2f(nw) * (0.25f * 0.125f);
        const int hn = hh < 15 ? hh + 1 : 15;
        nb0 = *(const bf16x8*)(zq + hn * 64); nb1 = *(const bf16x8*)(zq + hn * 64 + 32); nw = zw[hn];
#pragma unroll
        for (int m = 0; m < 8; ++m) { f32x4 acc = {0.f, 0.f, 0.f, 0.f}; acc = MFMA16(ak[m][0], b0, acc); acc = MFMA16(ak[m][1], b1, acc);
#pragma unroll
            for (int r = 0; r < 4; ++r) sc[m][r] += wgt * fmaxf(acc[r], 0.f); }
    }
#pragma unroll
    for (int m = 0; m < 8; ++m) *(f32x4*)(SC + tq * SEQ + kt * 128 + m * 16 + 4 * fq) = sc[m];
}
template <int NJ> __device__ __forceinline__ void topk_row(const float* __restrict__ row, int nv, int* __restrict__ out, int lane) {
    unsigned key[NJ];
#pragma unroll
    for (int j = 0; j < NJ; ++j) { const int e = j * 64 + lane; const int ec = e < nv ? e : nv - 1; const unsigned uu = __builtin_bit_cast(unsigned, row[ec]);
        const unsigned k = (uu & 0x80000000u) ? ~uu : (uu | 0x80000000u); key[j] = e < nv ? k : 0u; }
    unsigned thr = 0u;
#pragma unroll 1
    for (int bit = 31; bit >= 0; --bit) { const unsigned cand = thr | (1u << bit); int cnt = 0;
#pragma unroll
        for (int j = 0; j < NJ; ++j) cnt += __popcll(__ballot(key[j] >= cand));
        if (cnt >= 256) thr = cand; }
    int cgt = 0;
#pragma unroll
    for (int j = 0; j < NJ; ++j) cgt += __popcll(__ballot(key[j] > thr));
    const int need = 256 - cgt; int base = 0, eqb = 0;
    const unsigned long long lt = (1ull << lane) - 1ull;
#pragma unroll
    for (int j = 0; j < NJ; ++j) { const bool gt = key[j] > thr, eq = key[j] == thr; const unsigned long long meq = __ballot(eq);
        const bool sel = gt || (eq && (eqb + __popcll(meq & lt)) < need); const unsigned long long ms = __ballot(sel);
        if (sel) out[base + __popcll(ms & lt)] = j * 64 + lane;
        base += __popcll(ms); eqb += __popcll(meq); }
}
__device__ __forceinline__ void phase_topk(const Params& p) {
    const int lane = TIDX() & 63, wave = TIDX() >> 6;
    const float* SC = (const float*)(p.ws + WS_SC); int* IDX = (int*)(p.ws + WS_IDX);
    for (int k = BIDX() * 8 + wave; k < 4096; k += gridDim.x * 8) {
        const int b = k >> 11, tb0 = k & 2047;
        for (int hf = 0; hf < 2; ++hf) {
            const int tb = hf ? 4095 - tb0 : tb0, t = b * SEQ + tb, nv = tb + 1; int* out = IDX + (size_t)t * 256;
            if (nv <= 256) { for (int q = lane; q < 256; q += 64) out[q] = q < nv ? q : -1; continue; }
            const float* row = SC + (size_t)t * SEQ; const int nj = (nv + 63) >> 6;
            if (nj <= 16) topk_row<16>(row, nv, out, lane);
            else if (nj <= 32) topk_row<32>(row, nv, out, lane);
            else if (nj <= 48) topk_row<48>(row, nv, out, lane);
            else topk_row<64>(row, nv, out, lane);
        }
    }
}
__device__ __forceinline__ s16x4 tr_read(const unsigned char* pl) {
    typedef short v4i16_t __attribute__((ext_vector_type(4)));
    return __builtin_bit_cast(s16x4, __builtin_amdgcn_ds_read_tr16_b64_v4i16((LAS v4i16_t*)(pl)));
}
__device__ __forceinline__ int rel_bucket(int rel) {
    if (rel < 16) return rel;
    const int v = 16 + (int)(log2f((float)rel * 0.0625f) * (16.f / 3.f));
    return v < 31 ? v : 31;
}
__device__ __forceinline__ void phase_attn(const Params& p, unsigned char* smem) {
    const int tid = TIDX(), lane = tid & 63, wave = tid >> 6, fr = lane & 15, fq = lane >> 4;
    const bf16_t* Z = (const bf16_t*)(p.ws + WS_Z); const bf16_t* KVN = (const bf16_t*)(p.ws + WS_KVN); const int* IDX = (const int*)(p.ws + WS_IDX); bf16_t* OLAT = (bf16_t*)(p.ws + WS_SC);
    float* BT = (float*)(smem + 135168);
    BT[tid] = p.rel_bias[tid];
    __syncthreads();
    unsigned char* kvl = smem + wave * 16896;
    const int q4 = (lane & 15) >> 2, p4 = lane & 3;
    for (int t = BIDX() * 8 + wave; t < NT; t += gridDim.x * 8) {
        const int tb = t & (SEQ - 1), nsel = tb + 1 < 256 ? tb + 1 : 256, nch = (nsel + 31) >> 5; const size_t bbase = (size_t)(t - tb);
        bf16x8 qf[8];
#pragma unroll
        for (int s = 0; s < 8; ++s) qf[s] = *(const bf16x8*)(Z + (size_t)t * NINP + ZQL + fr * 256 + 32 * s + 8 * fq);
        f32x4 O[16];
#pragma unroll
        for (int c = 0; c < 16; ++c) O[c] = (f32x4){0.f, 0.f, 0.f, 0.f};
        float m_run = -__builtin_inff(), l_run = 0.f;
        int idxr[4];
#pragma unroll
        for (int k = 0; k < 4; ++k) idxr[k] = IDX[(size_t)t * 256 + k * 64 + lane];
        u32x4 pre[16];
#pragma unroll
        for (int r = 0; r < 16; ++r) { int ridx = __shfl(idxr[0], 2 * r + (lane >> 5)); ridx = ridx < 0 ? 0 : ridx; pre[r] = *(const u32x4*)(KVN + (bbase + ridx) * 256 + (lane & 31) * 8); }
#pragma unroll 1
        for (int ch = 0; ch < nch; ++ch) {
            const int k2 = ch >> 1; const int cur = k2 == 0 ? idxr[0] : (k2 == 1 ? idxr[1] : (k2 == 2 ? idxr[2] : idxr[3]));
            const int myidx = __shfl(cur, (ch & 1) * 32 + (lane & 31));
            LDS_WAIT();
#pragma unroll
            for (int r = 0; r < 16; ++r) *(u32x4*)(kvl + (2 * r + (lane >> 5)) * 528 + (lane & 31) * 16) = pre[r];
            if (ch + 1 < nch) { const int k3 = (ch + 1) >> 1; const int nxt = k3 == 0 ? idxr[0] : (k3 == 1 ? idxr[1] : (k3 == 2 ? idxr[2] : idxr[3]));
#pragma unroll
                for (int r = 0; r < 16; ++r) { int ridx = __shfl(nxt, ((ch + 1) & 1) * 32 + 2 * r + (lane >> 5)); ridx = ridx < 0 ? 0 : ridx; pre[r] = *(const u32x4*)(KVN + (bbase + ridx) * 256 + (lane & 31) * 8); } }
            LDS_WAIT();
            f32x4 s0 = {0.f, 0.f, 0.f, 0.f}, s1 = {0.f, 0.f, 0.f, 0.f};
#pragma unroll
            for (int s = 0; s < 8; ++s) { const bf16x8 a0 = *(const bf16x8*)(kvl + fr * 528 + (4 * s + fq) * 16), a1 = *(const bf16x8*)(kvl + (16 + fr) * 528 + (4 * s + fq) * 16);
                s0 = MFMA16(a0, qf[s], s0); s1 = MFMA16(a1, qf[s], s1); }
            float lg0[4], lg1[4]; float cmax = -__builtin_inff();
#pragma unroll
            for (int r = 0; r < 4; ++r) { const int i0 = __shfl(myidx, 4 * fq + r), i1 = __shfl(myidx, 16 + 4 * fq + r);
                lg0[r] = i0 >= 0 ? s0[r] * 0.0625f + BT[rel_bucket(tb - i0) * 16 + fr] : -__builtin_inff();
                lg1[r] = i1 >= 0 ? s1[r] * 0.0625f + BT[rel_bucket(tb - i1) * 16 + fr] : -__builtin_inff();
                cmax = fmaxf(cmax, fmaxf(lg0[r], lg1[r])); }
            cmax = fmaxf(cmax, __shfl_xor(cmax, 16)); cmax = fmaxf(cmax, __shfl_xor(cmax, 32));
            const float m_new = fmaxf(m_run, cmax), alpha = __expf(m_run - m_new);
            float ps = 0.f; float pp[8];
#pragma unroll
            for (int r = 0; r < 4; ++r) { pp[r] = __expf(lg0[r] - m_new); pp[4 + r] = __expf(lg1[r] - m_new); ps += pp[r] + pp[4 + r]; }
            l_run = l_run * alpha + ps; m_run = m_new;
            u32x4 pw; pw.x = pk2(pp[0], pp[1]); pw.y = pk2(pp[2], pp[3]); pw.z = pk2(pp[4], pp[5]); pw.w = pk2(pp[6], pp[7]);
            const bf16x8 pb = __builtin_bit_cast(bf16x8, pw);
#pragma unroll
            for (int c = 0; c < 16; ++c) {
                const s16x4 v0 = tr_read(kvl + (4 * fq + q4) * 528 + 32 * c + 8 * p4), v1 = tr_read(kvl + (16 + 4 * fq + q4) * 528 + 32 * c + 8 * p4);
                bf16x8 af; af[0] = v0[0]; af[1] = v0[1]; af[2] = v0[2]; af[3] = v0[3]; af[4] = v1[0]; af[5] = v1[1]; af[6] = v1[2]; af[7] = v1[3];
                O[c] = MFMA16(af, pb, O[c] * alpha); }
        }
        float lt = l_run; lt += __shfl_xor(lt, 16); lt += __shfl_xor(lt, 32);
        const float inv = 1.f / lt;
#pragma unroll
        for (int c = 0; c < 16; ++c) { u32x2 o; o.x = pk2(O[c][0] * inv, O[c][1] * inv); o.y = pk2(O[c][2] * inv, O[c][3] * inv);
            *(u32x2*)(OLAT + (size_t)t * 4096 + fr * 256 + 16 * c + 4 * fq) = o; }
    }
}
__device__ __forceinline__ void upproj_unit(const Params& p, int u) {
    const int lane = TIDX() & 63, wave = TIDX() >> 6, fr = lane & 15, fq = lane >> 4;
    const int tt = u >> 4, hh = u & 15;
    const bf16_t* Z = (const bf16_t*)(p.ws + WS_Z); const bf16_t* OLAT = (const bf16_t*)(p.ws + WS_SC); const bf16_t* WuvT = (const bf16_t*)(p.ws + WS_WUV) + (size_t)hh * 128 * 256; bf16_t* MRG = (bf16_t*)(p.ws + WS_MRG);
    const size_t t = (size_t)tt * 128 + wave * 16 + fr;
    bf16x8 of[8];
#pragma unroll
    for (int s = 0; s < 8; ++s) of[s] = *(const bf16x8*)(OLAT + t * 4096 + hh * 256 + 32 * s + 8 * fq);
    u32x2 gr[8], mr[8];
#pragma unroll
    for (int j = 0; j < 8; ++j) { const int col = hh * 128 + 16 * j + 4 * fq; gr[j] = *(const u32x2*)(Z + t * NINP + ZGD + col); mr[j] = *(const u32x2*)(MRG + t * DM + col); }
    f32x4 acc[8];
#pragma unroll
    for (int j = 0; j < 8; ++j) { acc[j] = (f32x4){0.f, 0.f, 0.f, 0.f};
#pragma unroll
        for (int s = 0; s < 8; ++s) { const bf16x8 wf = *(const bf16x8*)(WuvT + (size_t)(16 * j + fr) * 256 + 32 * s + 8 * fq); acc[j] = MFMA16(wf, of[s], acc[j]); } }
#pragma unroll
    for (int j = 0; j < 8; ++j) { const int col = hh * 128 + 16 * j + 4 * fq;
        const float o0 = bf2f(mr[j].x & 0xffffu) + sigmoidf_(bf2f(gr[j].x & 0xffffu)) * acc[j][0], o1 = bf2f(mr[j].x >> 16) + sigmoidf_(bf2f(gr[j].x >> 16)) * acc[j][1];
        const float o2 = bf2f(mr[j].y & 0xffffu) + sigmoidf_(bf2f(gr[j].y & 0xffffu)) * acc[j][2], o3 = bf2f(mr[j].y >> 16) + sigmoidf_(bf2f(gr[j].y >> 16)) * acc[j][3];
        u32x2 o; o.x = pk2(o0, o1); o.y = pk2(o2, o3); *(u32x2*)(MRG + t * DM + col) = o; }
}

__device__ __forceinline__ void gemm_store(unsigned char* smem, const bf16_t* A, const bf16_t* Bt, int N, int K, bf16_t* O, int act) {
    pg8::Gemm g; g.A = A; g.Bt = Bt; g.M = NT; g.N = N; g.K = K;
    pg8::StaticOrder S; S.init(NT, N, (int)gridDim.x, (int)BIDX());
    if (act) { EpiStoreBf16<1> E; E.O = O; E.ldc = N; pg8::gemm_phase<EpiStoreBf16<1>, pg8::StaticOrder, true, true>((PG8_LAS unsigned char*)smem, g, S, E); }
    else { EpiStoreBf16<0> E; E.O = O; E.ldc = N; pg8::gemm_phase<EpiStoreBf16<0>, pg8::StaticOrder, true, true>((PG8_LAS unsigned char*)smem, g, S, E); }
}
__device__ __forceinline__ void gemm_resid(unsigned char* smem, const bf16_t* A, const bf16_t* Bt, int K, const float* base, float* out, const float* gate) {
    pg8::Gemm g; g.A = A; g.Bt = Bt; g.M = NT; g.N = DM; g.K = K;
    pg8::StaticOrder S; S.init(NT, DM, (int)gridDim.x, (int)BIDX());
    EpiResidual E; E.base = base; E.out = out; E.gate = gate;
    pg8::gemm_phase<EpiResidual, pg8::StaticOrder, true, true>((PG8_LAS unsigned char*)smem, g, S, E);
}

#ifndef PROBE_REP
#define PROBE_REP 0
#endif
#define NREP(bit) (1 + ((PROBE_REP >> (bit)) & 1))
__global__ void __launch_bounds__(512) mega(Params p) {
    extern __shared__ __attribute__((aligned(16))) unsigned char smem[];
    cg::grid_group grid = cg::this_grid();
    const float* MOD = (const float*)(p.ws + WS_MOD);
    bf16_t* H = (bf16_t*)(p.ws + WS_H); bf16_t* Zb = (bf16_t*)(p.ws + WS_Z); bf16_t* MRG = (bf16_t*)(p.ws + WS_MRG); bf16_t* HID = (bf16_t*)(p.ws + WS_UT);
    const bf16_t* WinT = (const bf16_t*)(p.ws + WS_WIN); const bf16_t* WoutT = (const bf16_t*)(p.ws + WS_WOUT); const bf16_t* W1T = (const bf16_t*)(p.ws + WS_W1); const bf16_t* W2T = (const bf16_t*)(p.ws + WS_W2);
    for (int ph = p.ph_lo; ph < p.ph_hi; ++ph) {
        if (ph == 0) { for (int rep = 0; rep < NREP(8); ++rep) { phase_modp(p, smem); phase_convert(p, 0, smem); } }
        else if (ph == 1) phase_modreduce(p);
        else if (ph == NPH - 1) phase_final(p.out, p.final_g, p.out);
        else {
            const int l = (ph - 2) / 10, s = (ph - 2) % 10; const float* mod = MOD + (size_t)l * 2 * NMOD;
            if (s == 0) { if (l == 1) phase_convert(p, 1, smem); for (int rep = 0; rep < NREP(7); ++rep) phase_norm(l == 0 ? p.x : p.out, p.norm1_g + l * DM, mod + 0, mod + 2048, H); }
            else if (s == 1) { for (int rep = 0; rep < NREP(0); ++rep) gemm_store(smem, H, WinT, NINP, DM, Zb, 0); }
            else if (s == 2) { for (int rep = 0; rep < NREP(2); ++rep) for (int u = BIDX(); u < 512; u += gridDim.x) gla1_unit(p, l, u, smem); for (int rep = 0; rep < NREP(3); ++rep) { phase_kvnorm(p, l); for (int u = BIDX(); u < 1056; u += gridDim.x) score_unit(p, u); } }
            else if (s == 3) { phase_gla_scan(p); for (int rep = 0; rep < NREP(4); ++rep) phase_topk(p); }
            else if (s == 4) { for (int rep = 0; rep < NREP(5); ++rep) for (int u = BIDX(); u < 512; u += gridDim.x) gla3_unit(p, l, u, smem); for (int rep = 0; rep < NREP(6); ++rep) { __syncthreads(); phase_attn(p, smem); } }
            else if (s == 5) { for (int u = BIDX(); u < 1024; u += gridDim.x) upproj_unit(p, u); }
            else if (s == 6) gemm_resid(smem, MRG, WoutT, DM, l == 0 ? p.x : p.out, p.out, mod + 4096);
            else if (s == 7) phase_norm(p.out, p.norm2_g + l * DM, mod + 6144, mod + 8192, H);
            else if (s == 8) { for (int rep = 0; rep < NREP(1); ++rep) gemm_store(smem, H, W1T, DFF, DM, HID, 1); }
            else gemm_resid(smem, HID, W2T, DFF, p.out, p.out, mod + 10240);
        }
        if (ph + 1 < p.ph_hi) grid.sync();
    }
}

extern "C" void kernel_launch(void* const* d_in, const int* in_sizes, int n_in, void* d_out, int out_size, void* d_ws, size_t ws_size, hipStream_t stream) {
    static int grid = 0;
    if (grid == 0) {
        if (n_in != 17 || out_size != NT * DM || ws_size < WS_END) { fprintf(stderr, "kernel_launch: unexpected shapes (n_in %d out %d ws %zu need %zu)\n", n_in, out_size, ws_size, (size_t)WS_END); grid = -1; return; }
        if (hipFuncSetAttribute((const void*)mega, hipFuncAttributeMaxDynamicSharedMemorySize, LDS_BYTES) != hipSuccess) { fprintf(stderr, "kernel_launch: hipFuncSetAttribute failed\n"); grid = -1; return; }
        int dev = 0, cus = 0, per_cu = 0;
        hipGetDevice(&dev); hipDeviceGetAttribute(&cus, hipDeviceAttributeMultiprocessorCount, dev);
        hipOccupancyMaxActiveBlocksPerMultiprocessor(&per_cu, (const void*)mega, 512, LDS_BYTES);
        if (per_cu < 1) { fprintf(stderr, "kernel_launch: occupancy query says %d blocks per CU\n", per_cu); }
        (void)hipGetLastError();
        grid = cus > 0 ? cus : 256;
    }
    if (grid < 0) return;
    Params p{};
    const float** pp = (const float**)&p;
    for (int i = 0; i < 17; ++i) pp[i] = (const float*)d_in[i];
    p.out = (float*)d_out; p.ws = (unsigned char*)d_ws;
#if MK_SINGLE
    p.ph_lo = 0; p.ph_hi = NPH;
    void* args[] = {&p};
    hipError_t e = hipLaunchCooperativeKernel((const void*)mega, dim3(grid), dim3(512), args, LDS_BYTES, stream);
    if (e != hipSuccess) fprintf(stderr, "cooperative launch failed: %s (grid %d)\n", hipGetErrorString(e), grid);
#else
    for (int ph = 0; ph < NPH; ++ph) { p.ph_lo = ph; p.ph_hi = ph + 1; hipLaunchKernelGGL(mega, dim3(grid), dim3(512), LDS_BYTES, stream, p); }
#endif
}
```

```cpp
#include <hip/hip_runtime.h>
#include <hip/hip_cooperative_groups.h>
#include <cstdio>
#include <cstdint>
namespace cg = cooperative_groups;
#ifndef MK_SINGLE
#define MK_SINGLE 1
#endif
__device__ __forceinline__ int TIDX() { int t = threadIdx.x; asm volatile("" : "+v"(t)); return t; }
__device__ __forceinline__ int BIDX() { int t = blockIdx.x; asm volatile("" : "+s"(t)); return t; }
namespace pg8 {
#define PG8_LAS __attribute__((address_space(3)))
typedef unsigned short bf16_t;
typedef short bf16x8 __attribute__((ext_vector_type(8)));
typedef float f32x4 __attribute__((ext_vector_type(4)));
typedef unsigned u32x4 __attribute__((ext_vector_type(4)));
constexpr int BM = 256, BK = 64, HALF = 128, HTB = HALF * BK * 2  , STAGE_BYTES = 8 * HTB, NXCD = 8, WGM = 8;

__host__ __device__ __forceinline__ int lds_byte(int r, int c) { const int st = (r >> 4) * 2 + (c >> 5), rr = r & 15, cc = c & 31, ob = rr * 64 + cc * 2; return st * 1024 + (ob ^ (((ob >> 9) & 1) << 5)); }
__host__ __device__ __forceinline__ void stage_rc(int b, int& R, int& C) { const int st = b / 1024, sb = b % 1024, swz = sb ^ (((sb >> 9) & 1) << 5); R = (st >> 1) * 16 + swz / 64; C = (st & 1) * 32 + (swz % 64) / 2; }
__host__ __device__ __forceinline__ int perm32(int rho) { const int n = rho >> 4, i = rho & 15; return 8 * (i >> 2) + 4 * n + (i & 3); }

struct Unit { int pm, pn; };
struct Gemm { const bf16_t* A; const bf16_t* Bt; int M, N, K; };

struct StaticOrder {
    int nM, nN, nwg, G, c;
    __host__ __device__ void init(int M, int N, int G_, int c_) { nM = M / BM; nN = N / BM; nwg = nM * nN; G = G_; c = c_; }
    __host__ __device__ bool next(int i, Unit& u) const {
        const long L = (long)i * G + c; if (L >= nwg) return false;
        int wgid = (int)L; { const int q = nwg / NXCD, r = nwg % NXCD, xcd = wgid % NXCD, off = wgid / NXCD; wgid = (xcd < r ? xcd * (q + 1) : r * (q + 1) + (xcd - r) * q) + off; }
        const int nig = WGM * nN, gid = wgid / nig, fm = gid * WGM, gsz = (nM - fm) < WGM ? (nM - fm) : WGM;
        u.pm = fm + ((wgid % nig) % gsz); u.pn = (wgid % nig) / gsz; return true;
    }
    __device__ __forceinline__ void a_ready(const Unit&) const {}
    __device__ __forceinline__ void done(const Unit&) const {}
};

__device__ __forceinline__ unsigned cvt_pk_bf16(float lo, float hi) { unsigned r; asm volatile("v_cvt_pk_bf16_f32 %0, %1, %2" : "=v"(r) : "v"(lo), "v"(hi)); return r; }
template <class Epi, class Sched, bool ALIGN_EPI = false, bool SP2 = false>
__device__ __forceinline__ void gemm_phase(PG8_LAS unsigned char* lds, const Gemm g, const Sched& S, const Epi& E) {
    const int tid = TIDX(), wid = __builtin_amdgcn_readfirstlane(tid >> 6), lane = tid & 63, wr = wid >> 2, wc = wid & 3, fr = lane & 15, fq = lane >> 4;
    const int K = g.K, nt = K / BK;
    unsigned voffA[2], voffB[2];
#pragma unroll
    for (int i = 0; i < 2; ++i) { int R, C; stage_rc(tid * 16 + i * 8192, R, C); const int Rb = Epi::PERM ? ((R & ~31) + perm32(R & 31)) : R;
        voffA[i] = (unsigned)(R * K + C) * 2u; voffB[i] = (unsigned)(Rb * K + C) * 2u; }
    const size_t kstep = (size_t)(BK * 2);
    const size_t hstep = (size_t)HALF * K * 2;
    const size_t tstep = 2 * hstep;
    const unsigned ldsw = (unsigned)wid * 1024u;
    const int aoff = lds_byte(wr * 64 + fr, fq * 8), boff = lds_byte(wc * 32 + fr, fq * 8);
#define PG8_SA(b, h) (((b) * 2 + (h)) * HTB)
#define PG8_SB(b, h) ((4 + (b) * 2 + (h)) * HTB)
#define PG8_STAGE(bufoff, gbase, voff) do { _Pragma("unroll") for (int _i = 0; _i < 2; ++_i) \
        __builtin_amdgcn_global_load_lds((const unsigned*)((const char*)(gbase) + (voff)[_i]), (PG8_LAS unsigned*)(lds + (bufoff) + ldsw + _i * 8192), 16, 0, 0); } while (0)
#define PG8_LDA(dst, b, h) do { _Pragma("unroll") for (int m = 0; m < 4; ++m) _Pragma("unroll") for (int k = 0; k < 2; ++k) dst[m][k] = *(const PG8_LAS bf16x8*)(lds + PG8_SA(b, h) + aoff + m * 2048 + k * 1024); } while (0)
#define PG8_LDB(dst, b, h) do { _Pragma("unroll") for (int n = 0; n < 2; ++n) _Pragma("unroll") for (int k = 0; k < 2; ++k) dst[n][k] = *(const PG8_LAS bf16x8*)(lds + PG8_SB(b, h) + boff + n * 2048 + k * 1024); } while (0)
#define PG8_MMA(ai, bj, At, Bt) do { __builtin_amdgcn_s_setprio(1); _Pragma("unroll") for (int m = 0; m < 4; ++m) _Pragma("unroll") for (int n = 0; n < 2; ++n) _Pragma("unroll") for (int k = 0; k < 2; ++k) \
        acc[ai][bj][m][n] = __builtin_amdgcn_mfma_f32_16x16x32_bf16(Bt[n][k], At[m][k], acc[ai][bj][m][n], 0, 0, 0); __builtin_amdgcn_s_setprio(0); } while (0)
#define PG8_WAIT_V(n) asm volatile("s_waitcnt vmcnt(" #n ")" ::: "memory")
#define PG8_WAIT_L(n) asm volatile("s_waitcnt lgkmcnt(" #n ")" ::: "memory")
#define PG8_BAR __builtin_amdgcn_s_barrier()
#define PG8_SCHED __builtin_amdgcn_sched_barrier(0)
    Unit cur, nxt; int ui = 0;
    if (!S.next(0, cur)) return;
    f32x4 acc[2][2][4][2];
#pragma unroll
    for (int a = 0; a < 2; ++a)
#pragma unroll
        for (int b = 0; b < 2; ++b)
#pragma unroll
            for (int m = 0; m < 4; ++m)
#pragma unroll
                for (int n = 0; n < 2; ++n) acc[a][b][m][n] = (f32x4){0.f, 0.f, 0.f, 0.f};
    bf16x8 At[4][2], B0[2][2], B1[2][2];
    const char* cA = (const char*)g.A + (size_t)cur.pm * tstep; const char* cB = (const char*)g.Bt + (size_t)cur.pn * tstep;
    S.a_ready(cur);
    if constexpr (SP2) {
        PG8_STAGE(PG8_SB(0, 0), cB, voffB); PG8_STAGE(PG8_SB(0, 1), cB + hstep, voffB); PG8_STAGE(PG8_SA(0, 0), cA, voffA); PG8_STAGE(PG8_SA(0, 1), cA + hstep, voffA);
        if (wr == 1) PG8_BAR;
        PG8_WAIT_V(2); PG8_BAR;
        PG8_STAGE(PG8_SB(1, 0), cB + kstep, voffB); PG8_STAGE(PG8_SA(1, 0), cA + kstep, voffA); PG8_STAGE(PG8_SB(1, 1), cB + hstep + kstep, voffB);
        PG8_WAIT_V(6); PG8_BAR;
    } else {
        PG8_STAGE(PG8_SB(0, 0), cB, voffB); PG8_STAGE(PG8_SA(0, 0), cA, voffA); PG8_STAGE(PG8_SB(0, 1), cB + hstep, voffB); PG8_STAGE(PG8_SA(0, 1), cA + hstep, voffA);
        if (wr == 1) PG8_BAR;
        PG8_WAIT_V(4); PG8_BAR;
        PG8_STAGE(PG8_SB(1, 0), cB + kstep, voffB); PG8_STAGE(PG8_SA(1, 0), cA + kstep, voffA); PG8_STAGE(PG8_SB(1, 1), cB + hstep + kstep, voffB);
        PG8_WAIT_V(6); PG8_BAR;
    }
    for (;;) {
        const bool has_next = S.next(ui + 1, nxt);
        const char* nA = has_next ? (const char*)g.A + (size_t)nxt.pm * tstep : cA; const char* nB = has_next ? (const char*)g.Bt + (size_t)nxt.pn * tstep : cB;
        for (int t = 0; t < nt; t += 2) {
            const bool last = (t == nt - 2);
            const char* a1 = cA + (size_t)(t + 1) * kstep;
            const char* a2 = last ? nA : cA + (size_t)(t + 2) * kstep; const char* b2 = last ? nB : cB + (size_t)(t + 2) * kstep;
            const char* a3 = a2 + kstep; const char* b3 = b2 + kstep;
            if (last && has_next) S.a_ready(nxt);
            if constexpr (SP2) {
            PG8_LDB(B0, 0, 0); PG8_LDB(B1, 0, 1); PG8_SCHED; PG8_LDA(At, 0, 0); PG8_STAGE(PG8_SA(1, 1), a1 + hstep, voffA);
            PG8_WAIT_V(8); PG8_WAIT_L(0); PG8_BAR; PG8_MMA(0, 0, At, B0); PG8_MMA(0, 1, At, B1); PG8_BAR; PG8_SCHED;
            PG8_LDA(At, 0, 1); PG8_STAGE(PG8_SB(0, 0), b2, voffB); PG8_STAGE(PG8_SB(0, 1), b2 + hstep, voffB); PG8_STAGE(PG8_SA(0, 0), a2, voffA);
            PG8_WAIT_V(8); PG8_WAIT_L(0); PG8_BAR; PG8_MMA(1, 0, At, B0); PG8_MMA(1, 1, At, B1); PG8_BAR; PG8_SCHED;
            PG8_LDB(B0, 1, 0); PG8_LDB(B1, 1, 1); PG8_SCHED; PG8_LDA(At, 1, 0); PG8_STAGE(PG8_SA(0, 1), a2 + hstep, voffA);
            PG8_WAIT_V(8); PG8_WAIT_L(0); PG8_BAR; PG8_MMA(0, 0, At, B0); PG8_MMA(0, 1, At, B1); PG8_BAR; PG8_SCHED;
            PG8_LDA(At, 1, 1); PG8_STAGE(PG8_SB(1, 0), b3, voffB); PG8_STAGE(PG8_SB(1, 1), b3 + hstep, voffB); PG8_STAGE(PG8_SA(1, 0), a3, voffA);
            PG8_WAIT_V(8); PG8_WAIT_L(0); PG8_BAR; PG8_MMA(1, 0, At, B0); PG8_MMA(1, 1, At, B1); PG8_BAR; PG8_SCHED;
            } else {
            PG8_LDB(B0, 0, 0); PG8_SCHED; PG8_LDA(At, 0, 0); PG8_STAGE(PG8_SA(1, 1), a1 + hstep, voffA);
            PG8_WAIT_L(8); PG8_BAR; PG8_WAIT_L(0); PG8_MMA(0, 0, At, B0); PG8_BAR; PG8_SCHED;
            PG8_LDB(B1, 0, 1); PG8_STAGE(PG8_SB(0, 0), b2, voffB);
            PG8_BAR; PG8_WAIT_L(0); PG8_MMA(0, 1, At, B1); PG8_BAR;
            PG8_LDA(At, 0, 1); PG8_STAGE(PG8_SA(0, 0), a2, voffA);
            PG8_BAR; PG8_WAIT_L(0); PG8_MMA(1, 0, At, B0); PG8_BAR; PG8_SCHED;
            PG8_STAGE(PG8_SB(0, 1), b2 + hstep, voffB);
            PG8_WAIT_V(6); PG8_BAR; PG8_MMA(1, 1, At, B1); PG8_BAR;
            PG8_LDB(B0, 1, 0); PG8_SCHED; PG8_LDA(At, 1, 0); PG8_STAGE(PG8_SA(0, 1), a2 + hstep, voffA);
            PG8_WAIT_L(8); PG8_BAR; PG8_WAIT_L(0); PG8_MMA(0, 0, At, B0); PG8_BAR; PG8_SCHED;
            PG8_LDB(B1, 1, 1); PG8_STAGE(PG8_SB(1, 0), b3, voffB);
            PG8_BAR; PG8_WAIT_L(0); PG8_MMA(0, 1, At, B1); PG8_BAR;
            PG8_LDA(At, 1, 1); PG8_STAGE(PG8_SA(1, 0), a3, voffA);
            PG8_BAR; PG8_WAIT_L(0); PG8_MMA(1, 0, At, B0); PG8_BAR; PG8_SCHED;
            PG8_STAGE(PG8_SB(1, 1), b3 + hstep, voffB);
            PG8_WAIT_V(6); PG8_BAR; PG8_MMA(1, 1, At, B1); PG8_BAR;
            }
        }
        if constexpr (ALIGN_EPI) { if (wr == 0) PG8_BAR; }
        if constexpr (!Epi::AFTER_DRAIN) { E(acc, cur, wr, wc, fr, fq); S.done(cur); }
        if (!has_next) break;
#pragma unroll
        for (int a = 0; a < 2; ++a)
#pragma unroll
            for (int b = 0; b < 2; ++b)
#pragma unroll
                for (int m = 0; m < 4; ++m)
#pragma unroll
                    for (int n = 0; n < 2; ++n) acc[a][b][m][n] = (f32x4){0.f, 0.f, 0.f, 0.f};
        cur = nxt; cA = nA; cB = nB; ++ui;
        if constexpr (ALIGN_EPI) { if (wr == 1) PG8_BAR; }
    }
    PG8_WAIT_V(0);
    if constexpr (!ALIGN_EPI) { if (wr == 0) PG8_BAR; }
    PG8_BAR;
    if constexpr (Epi::AFTER_DRAIN) { E.fused(acc, cur, wr, wc, fr, fq, lds, wid, lane); S.done(cur); }
#undef PG8_SA
#undef PG8_SB
#undef PG8_STAGE
#undef PG8_LDA
#undef PG8_LDB
#undef PG8_MMA
#undef PG8_WAIT_V
#undef PG8_WAIT_L
#undef PG8_BAR
#undef PG8_SCHED
}
}

using pg8::bf16_t; using pg8::bf16x8; using pg8::f32x4; using pg8::u32x4;
typedef unsigned u32x2 __attribute__((ext_vector_type(2)));
typedef short s16x4 __attribute__((ext_vector_type(4)));
#define LAS __attribute__((address_space(3)))

constexpr int DM = 2048, SEQ = 4096, NT = 8192, NINP = 15872, NIN = 15712, DFF = 8192, NMOD = 12288;
constexpr int ZQ = 0, ZK = 1024, ZV = 2048, ZA = 4096, ZR = 4112, ZQL = 6160, ZKV = 10256, ZIQ = 10512, ZIK = 11536, ZIW = 11600, ZGG = 11616, ZGD = 13664;
constexpr float EPS = 1e-6f;
constexpr int LDS_BYTES = 147456;
constexpr int NPH = 23;

constexpr size_t WS_WIN = 0;
constexpr size_t WS_WOUT = WS_WIN + (size_t)NINP * DM * 2;
constexpr size_t WS_W1 = WS_WOUT + (size_t)DM * DM * 2;
constexpr size_t WS_W2 = WS_W1 + (size_t)DFF * DM * 2;
constexpr size_t WS_WUV = WS_W2 + (size_t)DFF * DM * 2;
constexpr size_t WS_MODP = WS_WUV + (size_t)16 * 128 * 256 * 2;
constexpr size_t WS_MOD = WS_MODP + (size_t)2 * 64 * 2 * NMOD * 4;
constexpr size_t WS_H = WS_MOD + (size_t)2 * 2 * NMOD * 4;
constexpr size_t WS_Z = WS_H + (size_t)NT * DM * 2;
constexpr size_t WS_QT = WS_Z + (size_t)NT * NINP * 2;
constexpr size_t WS_AM = WS_QT + (size_t)NT * 1024 * 2;
constexpr size_t WS_VT = WS_AM + (size_t)512 * 64 * 64 * 2;
constexpr size_t WS_DEC = WS_VT + (size_t)512 * 512 * 64 * 2;
constexpr size_t WS_UT = WS_DEC + (size_t)512 * 256 * 4;
constexpr size_t WS_KVN = WS_UT + (size_t)512 * 512 * 256 * 2;
constexpr size_t WS_SC = WS_KVN + (size_t)NT * 256 * 2;
constexpr size_t WS_IDX = WS_SC + (size_t)NT * 4096 * 4;
constexpr size_t WS_MRG = WS_IDX + (size_t)NT * 256 * 4;
constexpr size_t WS_BAR = WS_MRG + (size_t)NT * DM * 2;
constexpr size_t WS_END = WS_BAR;

struct Params {
    const float *x, *c, *w_mod, *b_mod, *norm1_g, *w_in, *w_gate_up, *b_gate, *gla_norm_g, *kv_norm_g, *w_uv, *w_out, *norm2_g, *w_ff1, *w_ff2, *rel_bias, *final_g;
    float* out; unsigned char* ws; int ph_lo, ph_hi;
};

__device__ __forceinline__ unsigned f2bf(float f) { unsigned u = __builtin_bit_cast(unsigned, f); return (u + 0x7fffu + ((u >> 16) & 1u)) >> 16; }
__device__ __forceinline__ unsigned pk2(float lo, float hi) { return f2bf(lo) | (f2bf(hi) << 16); }
__device__ __forceinline__ float bf2f(unsigned v) { return __builtin_bit_cast(float, v << 16); }
__device__ __forceinline__ float wave_sum(float v) {
#pragma unroll
    for (int o = 1; o < 64; o <<= 1) v += __shfl_xor(v, o);
    return v;
}
#define LDS_WAIT() asm volatile("s_waitcnt lgkmcnt(0)" ::: "memory")
__device__ __forceinline__ float sigmoidf_(float x) { return 1.f / (1.f + __expf(-x)); }
__device__ __forceinline__ float logsig(float x) { return fminf(x, 0.f) - log1pf(expf(-fabsf(x))); }

template <int ACT> struct EpiStoreBf16 {
    static constexpr bool PERM = true, AFTER_DRAIN = false;
    bf16_t* O; int ldc;
    __device__ __forceinline__ void operator()(const f32x4 (&acc)[2][2][4][2], const pg8::Unit& u, int wr, int wc, int fr, int fq) const {
        const int row0 = u.pm * 256 + wr * 64 + fr, col0 = u.pn * 256 + wc * 32 + 8 * fq;
#pragma unroll
        for (int ai = 0; ai < 2; ++ai)
#pragma unroll
            for (int m = 0; m < 4; ++m) { bf16_t* rowp = O + (size_t)(row0 + ai * 128 + m * 16) * ldc + col0;
#pragma unroll
                for (int bj = 0; bj < 2; ++bj) { f32x4 v0 = acc[ai][bj][m][0], v1 = acc[ai][bj][m][1];
                    if (ACT == 1) {
#pragma unroll
                        for (int e = 0; e < 4; ++e) { float a = fmaxf(v0[e], 0.f), b = fmaxf(v1[e], 0.f); v0[e] = a * a; v1[e] = b * b; } }
                    u32x4 w; w.x = pk2(v0[0], v0[1]); w.y = pk2(v0[2], v0[3]); w.z = pk2(v1[0], v1[1]); w.w = pk2(v1[2], v1[3]);
                    *(u32x4*)(rowp + bj * 128) = w; } }
    }
};
struct EpiResidual {
    static constexpr bool PERM = false, AFTER_DRAIN = false;
    const float* base; float* out; const float* gate;
    __device__ __forceinline__ void operator()(const f32x4 (&acc)[2][2][4][2], const pg8::Unit& u, int wr, int wc, int fr, int fq) const {
        const int col0 = u.pn * 256 + wc * 32 + 4 * fq; const float* gb = gate + (size_t)((u.pm * 256) >> 12) * NMOD;
#pragma unroll
        for (int ai = 0; ai < 2; ++ai)
#pragma unroll
            for (int m = 0; m < 4; ++m) { const size_t off = (size_t)(u.pm * 256 + ai * 128 + wr * 64 + m * 16 + fr) * DM;
#pragma unroll
                for (int bj = 0; bj < 2; ++bj)
#pragma unroll
                    for (int n = 0; n < 2; ++n) { const int c = col0 + bj * 128 + n * 16; const f32x4 gv = *(const f32x4*)(gb + c), bs = *(const f32x4*)(base + off + c);
                        *(f32x4*)(out + off + c) = bs + gv * acc[ai][bj][m][n]; } }
    }
};

__device__ __forceinline__ void transpose_item(const float* __restrict__ W, int K, int N, bf16_t* __restrict__ WT, float* scr, int item, int lane) {
    const int nblk = N / 32, kb = item / nblk, nb = item % nblk, k0 = 64 * kb, n0 = 32 * nb;
#pragma unroll 8
    for (int i = 0; i < 32; ++i) { const int kk = 2 * i + (lane >> 5); scr[kk * 33 + (lane & 31)] = W[(size_t)(k0 + kk) * N + n0 + (lane & 31)]; }
    LDS_WAIT();
    const int c = lane & 7;
#pragma unroll
    for (int j = 0; j < 4; ++j) { const int n = (lane >> 3) + 8 * j; const float* s = scr + (8 * c) * 33 + n;
        u32x4 o; o.x = pk2(s[0 * 33], s[1 * 33]); o.y = pk2(s[2 * 33], s[3 * 33]); o.z = pk2(s[4 * 33], s[5 * 33]); o.w = pk2(s[6 * 33], s[7 * 33]);
        *(u32x4*)(WT + (size_t)(n0 + n) * K + k0 + 8 * c) = o; }
    LDS_WAIT();
}
__device__ __forceinline__ void phase_convert(const Params& p, int l, unsigned char* smem) {
    const int tid = TIDX(), lane = tid & 63, wave = tid >> 6;
    float* scr = (float*)(smem + 16384 + wave * 8448);
    const int gw = BIDX() * 8 + wave, NGW = gridDim.x * 8;
    bf16_t* WinT = (bf16_t*)(p.ws + WS_WIN); bf16_t* WoutT = (bf16_t*)(p.ws + WS_WOUT); bf16_t* W1T = (bf16_t*)(p.ws + WS_W1); bf16_t* W2T = (bf16_t*)(p.ws + WS_W2); bf16_t* WuvT = (bf16_t*)(p.ws + WS_WUV);
    constexpr int I_IN = 32 * (NIN / 32), I_OUT = 32 * 64, I_1 = 32 * 256, I_2 = 128 * 64, I_UV = 16 * 16;
    constexpr int NITEMS = I_IN + I_OUT + I_1 + I_2 + I_UV;
    for (int it = gw; it < NITEMS; it += NGW) {
        int r = it;
        if (r < I_IN) { transpose_item(p.w_in + (size_t)l * DM * NIN, DM, NIN, WinT, scr, r, lane); continue; } r -= I_IN;
        if (r < I_OUT) { transpose_item(p.w_out + (size_t)l * DM * DM, DM, DM, WoutT, scr, r, lane); continue; } r -= I_OUT;
        if (r < I_1) { transpose_item(p.w_ff1 + (size_t)l * DM * DFF, DM, DFF, W1T, scr, r, lane); continue; } r -= I_1;
        if (r < I_2) { transpose_item(p.w_ff2 + (size_t)l * DFF * DM, DFF, DM, W2T, scr, r, lane); continue; } r -= I_2;
        { const int hh = r >> 4, ri = r & 15; transpose_item(p.w_uv + ((size_t)l * 16 + hh) * 256 * 128, 256, 128, WuvT + (size_t)hh * 128 * 256, scr, ri, lane); }
    }
    const int gt = BIDX() * 512 + tid, NGT = gridDim.x * 512;
    for (int i = gt; i < (NINP - NIN) * DM / 8; i += NGT) *(u32x4*)(WinT + (size_t)NIN * DM + (size_t)i * 8) = (u32x4){0u, 0u, 0u, 0u};
}
__device__ __forceinline__ void phase_modp(const Params& p, unsigned char* smem) {
    const int tid = TIDX(), lane = tid & 63, wave = tid >> 6;
    float* ca = (float*)smem;
    for (int i = tid; i < 2 * DM; i += 512) { const float v = p.c[i]; ca[i] = v / (1.f + expf(-v)); }
    __syncthreads();
    float* MODP = (float*)(p.ws + WS_MODP);
    const int gw = BIDX() * 8 + wave, NGW = gridDim.x * 8;
    for (int u = gw; u < 2 * 48 * 64; u += NGW) {
        const int l = u / (48 * 64), r = u % (48 * 64), cgp = r >> 6, kc = r & 63;
        const float* W = p.w_mod + (size_t)l * DM * NMOD + (size_t)(kc * 32) * NMOD + cgp * 256 + lane * 4;
        f32x4 a0 = {0.f, 0.f, 0.f, 0.f}, a1 = {0.f, 0.f, 0.f, 0.f};
#pragma unroll 8
        for (int rr = 0; rr < 32; ++rr) { const f32x4 w = *(const f32x4*)(W + (size_t)rr * NMOD); const float c0 = ca[kc * 32 + rr], c1 = ca[DM + kc * 32 + rr]; a0 += c0 * w; a1 += c1 * w; }
        float* o = MODP + ((size_t)(l * 64 + kc) * 2) * NMOD + cgp * 256 + lane * 4;
        *(f32x4*)o = a0; *(f32x4*)(o + NMOD) = a1;
    }
}
__device__ __forceinline__ void phase_modreduce(const Params& p) {
    const int gt = BIDX() * 512 + TIDX();
    const float* MODP = (const float*)(p.ws + WS_MODP); float* MOD = (float*)(p.ws + WS_MOD);
    for (int i = gt; i < 2 * 2 * NMOD; i += gridDim.x * 512) {
        const int l = i / (2 * NMOD), b = (i / NMOD) & 1, j = i % NMOD;
        float s = p.b_mod[l * NMOD + j];
        for (int kc = 0; kc < 64; ++kc) s += MODP[((size_t)(l * 64 + kc) * 2 + b) * NMOD + j];
        MOD[i] = s;
    }
}

__device__ __forceinline__ void phase_norm(const float* X, const float* g, const float* sh, const float* sc, bf16_t* H) {
    const int lane = TIDX() & 63, wave = TIDX() >> 6;
    const int NGW = gridDim.x * 8;
    for (int row = BIDX() * 8 + wave; row < NT; row += 2 * NGW) {
        const int row2 = row + NGW < NT ? row + NGW : row;
        f32x4 v[2][8]; float ss[2] = {0.f, 0.f};
#pragma unroll
        for (int q = 0; q < 2; ++q) { const float* xr = X + (size_t)(q ? row2 : row) * DM + lane * 4;
#pragma unroll
            for (int j = 0; j < 8; ++j) v[q][j] = *(const f32x4*)(xr + j * 256); }
#pragma unroll
        for (int q = 0; q < 2; ++q)
#pragma unroll
            for (int j = 0; j < 8; ++j) ss[q] += (v[q][j][0] * v[q][j][0] + v[q][j][1] * v[q][j][1]) + (v[q][j][2] * v[q][j][2] + v[q][j][3] * v[q][j][3]);
#pragma unroll
        for (int q = 0; q < 2; ++q) { const int rr = q ? row2 : row; const int b = rr >> 12; const float rstd = rsqrtf(wave_sum(ss[q]) * (1.f / DM) + EPS);
#pragma unroll
            for (int j = 0; j < 8; ++j) { const int c = j * 256 + lane * 4; const f32x4 gv = *(const f32x4*)(g + c), sv = *(const f32x4*)(sc + (size_t)b * NMOD + c), hv = *(const f32x4*)(sh + (size_t)b * NMOD + c);
                const f32x4 o = (v[q][j] * rstd * gv) * (1.f + sv) + hv; u32x2 w; w.x = pk2(o[0], o[1]); w.y = pk2(o[2], o[3]);
                *(u32x2*)(H + (size_t)rr * DM + c) = w; } }
    }
}
__device__ __forceinline__ void phase_final(const float* X, const float* g, float* out) {
    const int lane = TIDX() & 63, wave = TIDX() >> 6;
    for (int row = BIDX() * 8 + wave; row < NT; row += gridDim.x * 8) {
        const float* xr = X + (size_t)row * DM + lane * 4;
        f32x4 v[8]; float ss = 0.f;
#pragma unroll
        for (int j = 0; j < 8; ++j) { v[j] = *(const f32x4*)(xr + j * 256); ss += (v[j][0] * v[j][0] + v[j][1] * v[j][1]) + (v[j][2] * v[j][2] + v[j][3] * v[j][3]); }
        const float rstd = rsqrtf(wave_sum(ss) * (1.f / DM) + EPS);
#pragma unroll
        for (int j = 0; j < 8; ++j) { const int c = j * 256 + lane * 4; const f32x4 gv = *(const f32x4*)(g + c); *(f32x4*)(out + (size_t)row * DM + c) = v[j] * rstd * gv; }
    }
}
#include <cstdlib>
#include <vector>

#define XB_TMO      128
#define XB_XCNT(j)  (256  + 64 * (j))
#define XB_XSUB(j)  (1280 + 64 * (j))
#define XB_XGEN(j)  (2304 + 64 * (j))
#define XB_TOP      3328
#define XB_TOPGEN   3392
#define XCD_BAR_WORDS 3456
#define XB_SPIN_CAP (1u << 18)


__device__ __forceinline__ unsigned xb_ld(unsigned* p)              { return __hip_atomic_load(p, __ATOMIC_RELAXED, __HIP_MEMORY_SCOPE_AGENT); }
__device__ __forceinline__ unsigned xb_add(unsigned* p, unsigned v) { return __hip_atomic_fetch_add(p, v, __ATOMIC_RELAXED, __HIP_MEMORY_SCOPE_AGENT); }
__device__ __forceinline__ unsigned xb_xcc_id() { return (unsigned)__builtin_amdgcn_s_getreg((3 << 11) | 20) & 0xFu; }
#define XB_SPIN(cond, bar) do { unsigned _sp = 0; while (cond) { __builtin_amdgcn_s_sleep(1); \
    if ((++_sp & 255u) == 0u) { if (xb_ld(&(bar)[XB_TMO])) break; if (_sp > XB_SPIN_CAP) { atomicAdd(&(bar)[XB_TMO], 1u); break; } } } } while (0)

struct XcdBarrier {
    unsigned* bar; unsigned x;
    volatile LAS unsigned* st;
};

__device__ __forceinline__ XcdBarrier xcd_barrier_post(unsigned* bar, volatile LAS unsigned* st) {
    XcdBarrier b; b.bar = bar; b.x = xb_xcc_id(); b.st = st;
    if (threadIdx.x == 0) (void)xb_add(&bar[XB_XCNT(b.x)], 1u);
    return b;
}
__device__ __forceinline__ void xcd_barrier_complete(unsigned* bar, unsigned x, unsigned& nloc, unsigned& nx) {
    const unsigned G = gridDim.x * gridDim.y * gridDim.z;
    unsigned sum, cnt, mine, sp = 0u;
    for (;;) {
        sum = 0u; cnt = 0u; mine = 0u;
#pragma unroll
        for (unsigned j = 0; j < 16; ++j) { const unsigned c = xb_ld(&bar[XB_XCNT(j)]); sum += c; cnt += (c > 0u) ? 1u : 0u; mine = (j == x) ? c : mine; }
        if (sum == G) break;
        __builtin_amdgcn_s_sleep(1);
        if ((++sp & 255u) == 0u) { if (xb_ld(&bar[XB_TMO])) break; if (sp > XB_SPIN_CAP) { atomicAdd(&bar[XB_TMO], 1u); break; } }
    }
    nloc = mine > 0u ? mine : 1u; nx = cnt > 0u ? cnt : 1u;
}

__device__ __forceinline__ void xcd_barrier(const XcdBarrier& b) {
    asm volatile("s_waitcnt vmcnt(0)" ::: "memory");
    __syncthreads();
    if (threadIdx.x == 0) {
        unsigned* bar = b.bar;
        __builtin_amdgcn_s_waitcnt(0);
        unsigned nloc = b.st[0], nx = b.st[1];
        if (nloc == 0u) { xcd_barrier_complete(bar, b.x, nloc, nx); b.st[0] = nloc; b.st[1] = nx; }
        const unsigned old = xb_add(&bar[XB_XSUB(b.x)], 1u);
        const unsigned gen = old / nloc;
        if (old + 1u == (gen + 1u) * nloc) {
            __builtin_amdgcn_fence(__ATOMIC_RELEASE, "agent");
            asm volatile("s_waitcnt vmcnt(0)" ::: "memory");
            const unsigned og = xb_add(&bar[XB_TOP], 1u);
            const unsigned tg = og / nx;
            if (og + 1u == (tg + 1u) * nx) xb_add(&bar[XB_TOPGEN], 1u);
            else XB_SPIN(xb_ld(&bar[XB_TOPGEN]) == tg, bar);
            __builtin_amdgcn_fence(__ATOMIC_ACQUIRE, "agent");
            xb_add(&bar[XB_XGEN(b.x)], 1u);
            asm volatile("s_waitcnt vmcnt(0)" ::: "memory");
        } else {
            XB_SPIN(xb_ld(&bar[XB_XGEN(b.x)]) == gen, bar);
            __builtin_amdgcn_fence(__ATOMIC_ACQUIRE, "agent");
            asm volatile("s_waitcnt vmcnt(0)" ::: "memory");
        }
    }
    __syncthreads();
}

#define MFMA16(a, b, c) __builtin_amdgcn_mfma_f32_16x16x32_bf16((a), (b), (c), 0, 0, 0)
__device__ __forceinline__ float logsig_fast(float x) { return fminf(x, 0.f) - __logf(1.f + __expf(-fabsf(x))); }
__device__ __forceinline__ void gla1_unit(const Params& p, int l, int u, unsigned char* smem) {
    const int tid = TIDX(), lane = tid & 63, wave = tid >> 6, fr = lane & 15, fq = lane >> 4;
    const int b = u >> 8, c = (u >> 2) & 63, h = u & 3, t0 = b * SEQ + c * 64;
    const bf16_t* Z = (const bf16_t*)(p.ws + WS_Z);
    float* AL = (float*)smem;
    float* TOT = (float*)(smem + 4096);
    bf16_t* KST = (bf16_t*)(smem + 6144);
    bf16_t* QS = (bf16_t*)(smem + 43008);
    bf16_t* KI = (bf16_t*)(smem + 76800);
    bf16_t* VT = (bf16_t*)(smem + 43008);
    bf16_t* QT = (bf16_t*)(p.ws + WS_QT) + ((size_t)(b * 4 + h) * SEQ + c * 64) * 256; bf16_t* AM = (bf16_t*)(p.ws + WS_AM); bf16_t* VTG = (bf16_t*)(p.ws + WS_VT) + (size_t)u * 32768; float* DEC = (float*)(p.ws + WS_DEC); bf16_t* UT = (bf16_t*)(p.ws + WS_UT);
    for (int i = tid; i < 1024; i += 512) AL[i] = bf2f(Z[(size_t)(t0 + (i >> 4)) * NINP + ZA + (i & 15)]);
#pragma unroll
    for (int k = 0; k < 4; ++k) { const int i = tid + 512 * k, row = i >> 5, ch = i & 31; const bf16_t* zr = Z + (size_t)(t0 + row) * NINP + h * 256 + ch * 8;
        *(u32x4*)(QS + row * 264 + ch * 8) = *(const u32x4*)(zr + ZQ); *(u32x4*)(KI + row * 264 + ch * 8) = *(const u32x4*)(zr + ZK); }
    const int d = tid & 255, half = tid >> 8;
    float w[16];
#pragma unroll
    for (int r = 0; r < 16; ++r) w[r] = p.w_gate_up[((size_t)l * 16 + r) * 1024 + h * 256 + d];
    const float bias = p.b_gate[l * 1024 + h * 256 + d];
    __syncthreads();
    float g[32];
    {   float sum = 0.f;
#pragma unroll
        for (int pl = 0; pl < 32; ++pl) { const int pos = half * 32 + pl; float x = bias;
#pragma unroll
            for (int r = 0; r < 16; ++r) x += AL[pos * 16 + r] * w[r];
            g[pl] = logsig_fast(x) * (1.f / 16.f); sum += g[pl]; }
        TOT[half * 256 + d] = sum; }
    __syncthreads();
    {   const float blast = TOT[d] + TOT[256 + d], eb = __expf(blast); float run = half ? TOT[d] : 0.f;
#pragma unroll
        for (int p8 = 0; p8 < 4; ++p8) { unsigned ks[8];
#pragma unroll
            for (int e = 0; e < 8; ++e) { const int pl = p8 * 8 + e, pos = half * 32 + pl;
                run += g[pl];
                const float er = __expf(run), ier = __builtin_amdgcn_rcpf(er);
                const float qv = bf2f(QS[pos * 264 + d]), kv = bf2f(KI[pos * 264 + d]);
                QS[pos * 264 + d] = (bf16_t)f2bf(qv * 0.0625f * er);
                KI[pos * 264 + d] = (bf16_t)f2bf(kv * ier);
                ks[e] = f2bf(kv * (eb * ier)); }
            u32x4 o; o.x = ks[0] | (ks[1] << 16); o.y = ks[2] | (ks[3] << 16); o.z = ks[4] | (ks[5] << 16); o.w = ks[6] | (ks[7] << 16);
            *(u32x4*)(KST + d * 72 + half * 32 + p8 * 8) = o; }
        if (half == 0) DEC[u * 256 + d] = eb; }
    __syncthreads();
#pragma unroll
    for (int k = 0; k < 4; ++k) { const int i = tid + 512 * k, row = i >> 5, ch = i & 31; *(u32x4*)(QT + row * 256 + ch * 8) = *(const u32x4*)(QS + row * 264 + ch * 8); }
#pragma unroll
    for (int tt = 0; tt < 2; ++tt) { const int id = wave * 2 + tt, it = id >> 2, jt = id & 3; f32x4 acc = {0.f, 0.f, 0.f, 0.f};
        if (jt <= it) {
#pragma unroll
            for (int s = 0; s < 8; ++s) { const bf16x8 a = *(const bf16x8*)(QS + (it * 16 + fr) * 264 + 32 * s + 8 * fq), bb = *(const bf16x8*)(KI + (jt * 16 + fr) * 264 + 32 * s + 8 * fq);
                acc = MFMA16(a, bb, acc); } }
#pragma unroll
        for (int r = 0; r < 4; ++r) { const int i = it * 16 + 4 * fq + r, j = jt * 16 + fr; AM[(size_t)u * 4096 + i * 64 + j] = (bf16_t)f2bf(j <= i ? acc[r] : 0.f); } }
    __syncthreads();
    {   u32x4 vr[8];
#pragma unroll
        for (int it = 0; it < 8; ++it) vr[it] = *(const u32x4*)(Z + (size_t)(t0 + lane) * NINP + ZV + h * 512 + (wave * 8 + it) * 8);
#pragma unroll
        for (int it = 0; it < 8; ++it) { const int dv0 = (wave * 8 + it) * 8;
#pragma unroll
            for (int e = 0; e < 4; ++e) { VT[(dv0 + 2 * e) * 72 + lane] = (bf16_t)(vr[it][e] & 0xffffu); VT[(dv0 + 2 * e + 1) * 72 + lane] = (bf16_t)(vr[it][e] >> 16); } } }
    __syncthreads();
#pragma unroll
    for (int k = 0; k < 8; ++k) { const int i = tid + 512 * k, dv = i >> 3, pc = i & 7; *(u32x4*)(VTG + dv * 64 + pc * 8) = *(const u32x4*)(VT + dv * 72 + pc * 8); }
    {   bf16x8 bfr[4][2];
#pragma unroll
        for (int nt = 0; nt < 4; ++nt)
#pragma unroll
            for (int s = 0; s < 2; ++s) bfr[nt][s] = *(const bf16x8*)(VT + (wave * 64 + nt * 16 + fr) * 72 + 32 * s + 8 * fq);
#pragma unroll 4
        for (int mt = 0; mt < 16; ++mt) { const bf16x8 a0 = *(const bf16x8*)(KST + (mt * 16 + fr) * 72 + 8 * fq), a1 = *(const bf16x8*)(KST + (mt * 16 + fr) * 72 + 32 + 8 * fq);
#pragma unroll
            for (int nt = 0; nt < 4; ++nt) { f32x4 acc = {0.f, 0.f, 0.f, 0.f}; acc = MFMA16(a0, bfr[nt][0], acc); acc = MFMA16(a1, bfr[nt][1], acc);
                u32x2 o; o.x = pk2(acc[0], acc[1]); o.y = pk2(acc[2], acc[3]);
                *(u32x2*)(UT + (size_t)u * 131072 + (size_t)(wave * 64 + nt * 16 + fr) * 256 + mt * 16 + 4 * fq) = o; } } }
    __syncthreads();
}

__device__ __forceinline__ void phase_gla_scan(const Params& p) {
    bf16_t* UT = (bf16_t*)(p.ws + WS_UT); const float* DEC = (const float*)(p.ws + WS_DEC);
    for (int gid = BIDX() * 512 + TIDX(); gid < 131072; gid += gridDim.x * 512) {
        const int bh = gid >> 14, b = bh >> 2, h = bh & 3, e = (gid & 16383) * 8, d0 = e & 255;
        float s[8];
#pragma unroll
        for (int i = 0; i < 8; ++i) s[i] = 0.f;
        for (int c4 = 0; c4 < 64; c4 += 4) { u32x4 uu[4]; f32x4 da[4], db[4];
#pragma unroll
            for (int k = 0; k < 4; ++k) { const int u = (b * 64 + c4 + k) * 4 + h; uu[k] = *(const u32x4*)(UT + (size_t)u * 131072 + e); da[k] = *(const f32x4*)(DEC + u * 256 + d0); db[k] = *(const f32x4*)(DEC + u * 256 + d0 + 4); }
#pragma unroll
            for (int k = 0; k < 4; ++k) { const int u = (b * 64 + c4 + k) * 4 + h;
                u32x4 o; o.x = pk2(s[0], s[1]); o.y = pk2(s[2], s[3]); o.z = pk2(s[4], s[5]); o.w = pk2(s[6], s[7]);
                *(u32x4*)(UT + (size_t)u * 131072 + e) = o;
                s[0] = da[k][0] * s[0] + bf2f(uu[k][0] & 0xffffu); s[1] = da[k][1] * s[1] + bf2f(uu[k][0] >> 16);
                s[2] = da[k][2] * s[2] + bf2f(uu[k][1] & 0xffffu); s[3] = da[k][3] * s[3] + bf2f(uu[k][1] >> 16);
                s[4] = db[k][0] * s[4] + bf2f(uu[k][2] & 0xffffu); s[5] = db[k][1] * s[5] + bf2f(uu[k][2] >> 16);
                s[6] = db[k][2] * s[6] + bf2f(uu[k][3] & 0xffffu); s[7] = db[k][3] * s[7] + bf2f(uu[k][3] >> 16); } }
    }
}

__device__ __forceinline__ void gla3_unit(const Params& p, int l, int u, unsigned char* smem) {
    const int tid = TIDX(), lane = tid & 63, wave = tid >> 6, fr = lane & 15, fq = lane >> 4;
    const int b = u >> 8, c = (u >> 2) & 63, h = u & 3, t0 = b * SEQ + c * 64;
    const bf16_t* Z = (const bf16_t*)(p.ws + WS_Z);
    bf16_t* QS = (bf16_t*)smem;
    bf16_t* AS = (bf16_t*)(smem + 33792);
    float* RED = (float*)(smem + 43008);
    float* RSTD = (float*)(smem + 45056);
    const bf16_t* QT = (const bf16_t*)(p.ws + WS_QT) + ((size_t)(b * 4 + h) * SEQ + c * 64) * 256; const bf16_t* AM = (const bf16_t*)(p.ws + WS_AM) + (size_t)u * 4096;
    const bf16_t* VTG = (const bf16_t*)(p.ws + WS_VT) + (size_t)u * 32768; const bf16_t* ST = (const bf16_t*)(p.ws + WS_UT) + (size_t)u * 131072; bf16_t* MRG = (bf16_t*)(p.ws + WS_MRG);
#pragma unroll
    for (int k = 0; k < 4; ++k) { const int i = tid + 512 * k, row = i >> 5, ch = i & 31; *(u32x4*)(QS + row * 264 + ch * 8) = *(const u32x4*)(QT + row * 256 + ch * 8); }
    { const int row = tid >> 3, ch = tid & 7; *(u32x4*)(AS + row * 72 + ch * 8) = *(const u32x4*)(AM + row * 64 + ch * 8); }
    __syncthreads();
    const int dv0 = wave * 64;
    f32x4 acc[4][4];
#pragma unroll
    for (int mt = 0; mt < 4; ++mt)
#pragma unroll
        for (int nt = 0; nt < 4; ++nt) acc[mt][nt] = (f32x4){0.f, 0.f, 0.f, 0.f};
#pragma unroll
    for (int s = 0; s < 8; ++s) { bf16x8 a[4], bb[4];
#pragma unroll
        for (int mt = 0; mt < 4; ++mt) a[mt] = *(const bf16x8*)(QS + (mt * 16 + fr) * 264 + 32 * s + 8 * fq);
#pragma unroll
        for (int nt = 0; nt < 4; ++nt) bb[nt] = *(const bf16x8*)(ST + (size_t)(dv0 + nt * 16 + fr) * 256 + 32 * s + 8 * fq);
#pragma unroll
        for (int mt = 0; mt < 4; ++mt)
#pragma unroll
            for (int nt = 0; nt < 4; ++nt) acc[mt][nt] = MFMA16(a[mt], bb[nt], acc[mt][nt]); }
#pragma unroll
    for (int s = 0; s < 2; ++s) { bf16x8 a[4], bb[4];
#pragma unroll
        for (int mt = 0; mt < 4; ++mt) a[mt] = *(const bf16x8*)(AS + (mt * 16 + fr) * 72 + 32 * s + 8 * fq);
#pragma unroll
        for (int nt = 0; nt < 4; ++nt) bb[nt] = *(const bf16x8*)(VTG + (dv0 + nt * 16 + fr) * 64 + 32 * s + 8 * fq);
#pragma unroll
        for (int mt = 0; mt < 4; ++mt)
#pragma unroll
            for (int nt = 0; nt < 4; ++nt) acc[mt][nt] = MFMA16(a[mt], bb[nt], acc[mt][nt]); }
#pragma unroll
    for (int mt = 0; mt < 4; ++mt)
#pragma unroll
        for (int r = 0; r < 4; ++r) { float ss = 0.f;
#pragma unroll
            for (int nt = 0; nt < 4; ++nt) ss += acc[mt][nt][r] * acc[mt][nt][r];
            ss += __shfl_xor(ss, 1); ss += __shfl_xor(ss, 2); ss += __shfl_xor(ss, 4); ss += __shfl_xor(ss, 8);
            if (fr == 0) RED[wave * 64 + mt * 16 + 4 * fq + r] = ss; }
    __syncthreads();
    if (tid < 64) { float t = 0.f;
#pragma unroll
        for (int w8 = 0; w8 < 8; ++w8) t += RED[w8 * 64 + tid];
        RSTD[tid] = rsqrtf(t * (1.f / 512.f) + EPS); }
    __syncthreads();
    const float* gn = p.gla_norm_g + l * 512;
#pragma unroll
    for (int mt = 0; mt < 4; ++mt)
#pragma unroll
        for (int r = 0; r < 4; ++r) { const int i = mt * 16 + 4 * fq + r; const float rs = RSTD[i]; const size_t t = (size_t)(t0 + i);
#pragma unroll
            for (int nt = 0; nt < 4; ++nt) { const int dv = dv0 + nt * 16 + fr, col = h * 512 + dv;
                const float rv = bf2f(Z[t * NINP + ZR + col]), gv = bf2f(Z[t * NINP + ZGG + col]);
                acc[mt][nt][r] = acc[mt][nt][r] * rs * gn[dv] * (rv * sigmoidf_(rv)) * sigmoidf_(gv); } }
#pragma unroll
    for (int mt = 0; mt < 4; ++mt)
#pragma unroll
        for (int r = 0; r < 4; ++r) { const size_t t = (size_t)(t0 + mt * 16 + 4 * fq + r);
#pragma unroll
            for (int nt = 0; nt < 4; ++nt) MRG[t * DM + h * 512 + dv0 + nt * 16 + fr] = (bf16_t)f2bf(acc[mt][nt][r]); }
    __syncthreads();
}

__device__ __forceinline__ void phase_kvnorm(const Params& p, int l) {
    const int lane = TIDX() & 63, wave = TIDX() >> 6;
    const bf16_t* Z = (const bf16_t*)(p.ws + WS_Z); bf16_t* KVN = (bf16_t*)(p.ws + WS_KVN);
    const f32x4 gv = *(const f32x4*)(p.kv_norm_g + l * 256 + lane * 4);
    for (int row = BIDX() * 8 + wave; row < NT; row += gridDim.x * 8) {
        const u32x2 raw = *(const u32x2*)(Z + (size_t)row * NINP + ZKV + lane * 4);
        const float v0 = bf2f(raw.x & 0xffffu), v1 = bf2f(raw.x >> 16), v2 = bf2f(raw.y & 0xffffu), v3 = bf2f(raw.y >> 16);
        const float rstd = rsqrtf(wave_sum((v0 * v0 + v1 * v1) + (v2 * v2 + v3 * v3)) * (1.f / 256.f) + EPS);
        u32x2 o; o.x = pk2(v0 * rstd * gv[0], v1 * rstd * gv[1]); o.y = pk2(v2 * rstd * gv[2], v3 * rstd * gv[3]);
        *(u32x2*)(KVN + (size_t)row * 256 + lane * 4) = o;
    }
}
__device__ __forceinline__ void score_unit(const Params& p, int u) {
    const int lane = TIDX() & 63, wave = TIDX() >> 6, fr = lane & 15, fq = lane >> 4;
    const int b = u / 528, i = u % 528; int qt = 0; while ((qt + 1) * (qt + 2) / 2 <= i) ++qt; const int kt = i - qt * (qt + 1) / 2;
    const bf16_t* Z = (const bf16_t*)(p.ws + WS_Z); float* SC = (float*)(p.ws + WS_SC);
    const size_t tq = (size_t)b * SEQ + qt * 128 + wave * 16 + fr, tk0 = (size_t)b * SEQ + kt * 128;
    bf16x8 ak[8][2];
#pragma unroll
    for (int m = 0; m < 8; ++m)
#pragma unroll
        for (int s = 0; s < 2; ++s) ak[m][s] = *(const bf16x8*)(Z + (tk0 + m * 16 + fr) * NINP + ZIK + 32 * s + 8 * fq);
    f32x4 sc[8];
#pragma unroll
    for (int m = 0; m < 8; ++m) sc[m] = (f32x4){0.f, 0.f, 0.f, 0.f};
    const bf16_t* zq = Z + tq * NINP + ZIQ + 8 * fq; const bf16_t* zw = Z + tq * NINP + ZIW;
    bf16x8 nb0 = *(const bf16x8*)(zq), nb1 = *(const bf16x8*)(zq + 32); unsigned nw = zw[0];
#pragma unroll 1
    for (int hh = 0; hh < 16; ++hh) {
        const bf16x8 b0 = nb0, b1 = nb1; const float wgt = bf2f(nw) * (0.25f * 0.125f);
        const int hn = hh < 15 ? hh + 1 : 15;
        nb0 = *(const bf16x8*)(zq + hn * 64); nb1 = *(const bf16x8*)(zq + hn * 64 + 32); nw = zw[hn];
#pragma unroll
        for (int m = 0; m < 8; ++m) { f32x4 acc = {0.f, 0.f, 0.f, 0.f}; acc = MFMA16(ak[m][0], b0, acc); acc = MFMA16(ak[m][1], b1, acc);
#pragma unroll
            for (int r = 0; r < 4; ++r) sc[m][r] += wgt * fmaxf(acc[r], 0.f); }
    }
#pragma unroll
    for (int m = 0; m < 8; ++m) *(f32x4*)(SC + tq * SEQ + kt * 128 + m * 16 + 4 * fq) = sc[m];
}
template <int NJ> __device__ __forceinline__ void topk_row(const float* __restrict__ row, int nv, int* __restrict__ out, int lane) {
    unsigned key[NJ];
#pragma unroll
    for (int j = 0; j < NJ; ++j) { const int e = j * 64 + lane; const int ec = e < nv ? e : nv - 1; const unsigned uu = __builtin_bit_cast(unsigned, row[ec]);
        const unsigned k = (uu & 0x80000000u) ? ~uu : (uu | 0x80000000u); key[j] = e < nv ? k : 0u; }
    unsigned thr = 0u;
#pragma unroll 1
    for (int bit = 31; bit >= 0; --bit) { const unsigned cand = thr | (1u << bit); int cnt = 0;
#pragma unroll
        for (int j = 0; j < NJ; ++j) cnt += __popcll(__ballot(key[j] >= cand));
        if (cnt >= 256) thr = cand; }
    int cgt = 0;
#pragma unroll
    for (int j = 0; j < NJ; ++j) cgt += __popcll(__ballot(key[j] > thr));
    const int need = 256 - cgt; int base = 0, eqb = 0;
    const unsigned long long lt = (1ull << lane) - 1ull;
#pragma unroll
    for (int j = 0; j < NJ; ++j) { const bool gt = key[j] > thr, eq = key[j] == thr; const unsigned long long meq = __ballot(eq);
        const bool sel = gt || (eq && (eqb + __popcll(meq & lt)) < need); const unsigned long long ms = __ballot(sel);
        if (sel) out[base + __popcll(ms & lt)] = j * 64 + lane;
        base += __popcll(ms); eqb += __popcll(meq); }
}
__device__ __forceinline__ void phase_topk(const Params& p) {
    const int lane = TIDX() & 63, wave = TIDX() >> 6;
    const float* SC = (const float*)(p.ws + WS_SC); int* IDX = (int*)(p.ws + WS_IDX);
    for (int k = BIDX() * 8 + wave; k < 4096; k += gridDim.x * 8) {
        const int b = k >> 11, tb0 = k & 2047;
        for (int hf = 0; hf < 2; ++hf) {
            const int tb = hf ? 4095 - tb0 : tb0, t = b * SEQ + tb, nv = tb + 1; int* out = IDX + (size_t)t * 256;
            if (nv <= 256) { for (int q = lane; q < 256; q += 64) out[q] = q < nv ? q : -1; continue; }
            const float* row = SC + (size_t)t * SEQ; const int nj = (nv + 63) >> 6;
            if (nj <= 16) topk_row<16>(row, nv, out, lane);
            else if (nj <= 32) topk_row<32>(row, nv, out, lane);
            else if (nj <= 48) topk_row<48>(row, nv, out, lane);
            else topk_row<64>(row, nv, out, lane);
        }
    }
}
__device__ __forceinline__ s16x4 tr_read(const unsigned char* pl) {
    typedef short v4i16_t __attribute__((ext_vector_type(4)));
    return __builtin_bit_cast(s16x4, __builtin_amdgcn_ds_read_tr16_b64_v4i16((LAS v4i16_t*)(pl)));
}
__device__ __forceinline__ int rel_bucket(int rel) {
    if (rel < 16) return rel;
    const int v = 16 + (int)(log2f((float)rel * 0.0625f) * (16.f / 3.f));
    return v < 31 ? v : 31;
}
__device__ __forceinline__ void phase_attn(const Params& p, unsigned char* smem) {
    const int tid = TIDX(), lane = tid & 63, wave = tid >> 6, fr = lane & 15, fq = lane >> 4;
    const bf16_t* Z = (const bf16_t*)(p.ws + WS_Z); const bf16_t* KVN = (const bf16_t*)(p.ws + WS_KVN); const int* IDX = (const int*)(p.ws + WS_IDX); bf16_t* OLAT = (bf16_t*)(p.ws + WS_SC);
    float* BT = (float*)(smem + 135168);
    BT[tid] = p.rel_bias[tid];
    __syncthreads();
    unsigned char* kvl = smem + wave * 16896;
    const int q4 = (lane & 15) >> 2, p4 = lane & 3;
    for (int t = BIDX() * 8 + wave; t < NT; t += gridDim.x * 8) {
        const int tb = t & (SEQ - 1), nsel = tb + 1 < 256 ? tb + 1 : 256, nch = (nsel + 31) >> 5; const size_t bbase = (size_t)(t - tb);
        bf16x8 qf[8];
#pragma unroll
        for (int s = 0; s < 8; ++s) qf[s] = *(const bf16x8*)(Z + (size_t)t * NINP + ZQL + fr * 256 + 32 * s + 8 * fq);
        f32x4 O[16];
#pragma unroll
        for (int c = 0; c < 16; ++c) O[c] = (f32x4){0.f, 0.f, 0.f, 0.f};
        float m_run = -__builtin_inff(), l_run = 0.f;
        int idxr[4];
#pragma unroll
        for (int k = 0; k < 4; ++k) idxr[k] = IDX[(size_t)t * 256 + k * 64 + lane];
        u32x4 pre[16];
#pragma unroll
        for (int r = 0; r < 16; ++r) { int ridx = __shfl(idxr[0], 2 * r + (lane >> 5)); ridx = ridx < 0 ? 0 : ridx; pre[r] = *(const u32x4*)(KVN + (bbase + ridx) * 256 + (lane & 31) * 8); }
#pragma unroll 1
        for (int ch = 0; ch < nch; ++ch) {
            const int k2 = ch >> 1; const int cur = k2 == 0 ? idxr[0] : (k2 == 1 ? idxr[1] : (k2 == 2 ? idxr[2] : idxr[3]));
            const int myidx = __shfl(cur, (ch & 1) * 32 + (lane & 31));
            LDS_WAIT();
#pragma unroll
            for (int r = 0; r < 16; ++r) *(u32x4*)(kvl + (2 * r + (lane >> 5)) * 528 + (lane & 31) * 16) = pre[r];
            if (ch + 1 < nch) { const int k3 = (ch + 1) >> 1; const int nxt = k3 == 0 ? idxr[0] : (k3 == 1 ? idxr[1] : (k3 == 2 ? idxr[2] : idxr[3]));
#pragma unroll
                for (int r = 0; r < 16; ++r) { int ridx = __shfl(nxt, ((ch + 1) & 1) * 32 + 2 * r + (lane >> 5)); ridx = ridx < 0 ? 0 : ridx; pre[r] = *(const u32x4*)(KVN + (bbase + ridx) * 256 + (lane & 31) * 8); } }
            LDS_WAIT();
            f32x4 s0 = {0.f, 0.f, 0.f, 0.f}, s1 = {0.f, 0.f, 0.f, 0.f};
#pragma unroll
            for (int s = 0; s < 8; ++s) { const bf16x8 a0 = *(const bf16x8*)(kvl + fr * 528 + (4 * s + fq) * 16), a1 = *(const bf16x8*)(kvl + (16 + fr) * 528 + (4 * s + fq) * 16);
                s0 = MFMA16(a0, qf[s], s0); s1 = MFMA16(a1, qf[s], s1); }
            float lg0[4], lg1[4]; float cmax = -__builtin_inff();
#pragma unroll
            for (int r = 0; r < 4; ++r) { const int i0 = __shfl(myidx, 4 * fq + r), i1 = __shfl(myidx, 16 + 4 * fq + r);
                lg0[r] = i0 >= 0 ? s0[r] * 0.0625f + BT[rel_bucket(tb - i0) * 16 + fr] : -__builtin_inff();
                lg1[r] = i1 >= 0 ? s1[r] * 0.0625f + BT[rel_bucket(tb - i1) * 16 + fr] : -__builtin_inff();
                cmax = fmaxf(cmax, fmaxf(lg0[r], lg1[r])); }
            cmax = fmaxf(cmax, __shfl_xor(cmax, 16)); cmax = fmaxf(cmax, __shfl_xor(cmax, 32));
            const float m_new = fmaxf(m_run, cmax), alpha = __expf(m_run - m_new);
            float ps = 0.f; float pp[8];
#pragma unroll
            for (int r = 0; r < 4; ++r) { pp[r] = __expf(lg0[r] - m_new); pp[4 + r] = __expf(lg1[r] - m_new); ps += pp[r] + pp[4 + r]; }
            l_run = l_run * alpha + ps; m_run = m_new;
            u32x4 pw; pw.x = pk2(pp[0], pp[1]); pw.y = pk2(pp[2], pp[3]); pw.z = pk2(pp[4], pp[5]); pw.w = pk2(pp[6], pp[7]);
            const bf16x8 pb = __builtin_bit_cast(bf16x8, pw);
#pragma unroll
            for (int c = 0; c < 16; ++c) {
                const s16x4 v0 = tr_read(kvl + (4 * fq + q4) * 528 + 32 * c + 8 * p4), v1 = tr_read(kvl + (16 + 4 * fq + q4) * 528 + 32 * c + 8 * p4);
                bf16x8 af; af[0] = v0[0]; af[1] = v0[1]; af[2] = v0[2]; af[3] = v0[3]; af[4] = v1[0]; af[5] = v1[1]; af[6] = v1[2]; af[7] = v1[3];
                O[c] = MFMA16(af, pb, O[c] * alpha); }
        }
        float lt = l_run; lt += __shfl_xor(lt, 16); lt += __shfl_xor(lt, 32);
        const float inv = 1.f / lt;
#pragma unroll
        for (int c = 0; c < 16; ++c) { u32x2 o; o.x = pk2(O[c][0] * inv, O[c][1] * inv); o.y = pk2(O[c][2] * inv, O[c][3] * inv);
            *(u32x2*)(OLAT + (size_t)t * 4096 + fr * 256 + 16 * c + 4 * fq) = o; }
    }
}
__device__ __forceinline__ void upproj_unit(const Params& p, int u) {
    const int lane = TIDX() & 63, wave = TIDX() >> 6, fr = lane & 15, fq = lane >> 4;
    const int tt = u >> 4, hh = u & 15;
    const bf16_t* Z = (const bf16_t*)(p.ws + WS_Z); const bf16_t* OLAT = (const bf16_t*)(p.ws + WS_SC); const bf16_t* WuvT = (const bf16_t*)(p.ws + WS_WUV) + (size_t)hh * 128 * 256; bf16_t* MRG = (bf16_t*)(p.ws + WS_MRG);
    const size_t t = (size_t)tt * 128 + wave * 16 + fr;
    bf16x8 of[8];
#pragma unroll
    for (int s = 0; s < 8; ++s) of[s] = *(const bf16x8*)(OLAT + t * 4096 + hh * 256 + 32 * s + 8 * fq);
    u32x2 gr[8], mr[8];
#pragma unroll
    for (int j = 0; j < 8; ++j) { const int col = hh * 128 + 16 * j + 4 * fq; gr[j] = *(const u32x2*)(Z + t * NINP + ZGD + col); mr[j] = *(const u32x2*)(MRG + t * DM + col); }
    f32x4 acc[8];
#pragma unroll
    for (int j = 0; j < 8; ++j) { acc[j] = (f32x4){0.f, 0.f, 0.f, 0.f};
#pragma unroll
        for (int s = 0; s < 8; ++s) { const bf16x8 wf = *(const bf16x8*)(WuvT + (size_t)(16 * j + fr) * 256 + 32 * s + 8 * fq); acc[j] = MFMA16(wf, of[s], acc[j]); } }
#pragma unroll
    for (int j = 0; j < 8; ++j) { const int col = hh * 128 + 16 * j + 4 * fq;
        const float o0 = bf2f(mr[j].x & 0xffffu) + sigmoidf_(bf2f(gr[j].x & 0xffffu)) * acc[j][0], o1 = bf2f(mr[j].x >> 16) + sigmoidf_(bf2f(gr[j].x >> 16)) * acc[j][1];
        const float o2 = bf2f(mr[j].y & 0xffffu) + sigmoidf_(bf2f(gr[j].y & 0xffffu)) * acc[j][2], o3 = bf2f(mr[j].y >> 16) + sigmoidf_(bf2f(gr[j].y >> 16)) * acc[j][3];
        u32x2 o; o.x = pk2(o0, o1); o.y = pk2(o2, o3); *(u32x2*)(MRG + t * DM + col) = o; }
}

__device__ __forceinline__ void gemm_store(unsigned char* smem, const bf16_t* A, const bf16_t* Bt, int N, int K, bf16_t* O, int act) {
    pg8::Gemm g; g.A = A; g.Bt = Bt; g.M = NT; g.N = N; g.K = K;
    pg8::StaticOrder S; S.init(NT, N, (int)gridDim.x, (int)BIDX());
    if (act) { EpiStoreBf16<1> E; E.O = O; E.ldc = N; pg8::gemm_phase<EpiStoreBf16<1>, pg8::StaticOrder, true, true>((PG8_LAS unsigned char*)smem, g, S, E); }
    else { EpiStoreBf16<0> E; E.O = O; E.ldc = N; pg8::gemm_phase<EpiStoreBf16<0>, pg8::StaticOrder, true, true>((PG8_LAS unsigned char*)smem, g, S, E); }
}
__device__ __forceinline__ void gemm_resid(unsigned char* smem, const bf16_t* A, const bf16_t* Bt, int K, const float* base, float* out, const float* gate) {
    pg8::Gemm g; g.A = A; g.Bt = Bt; g.M = NT; g.N = DM; g.K = K;
    pg8::StaticOrder S; S.init(NT, DM, (int)gridDim.x, (int)BIDX());
    EpiResidual E; E.base = base; E.out = out; E.gate = gate;
    pg8::gemm_phase<EpiResidual, pg8::StaticOrder, true, true>((PG8_LAS unsigned char*)smem, g, S, E);
}

#ifndef PROBE_REP
#define PROBE_REP 0
#endif
#define NREP(bit) (1 + ((PROBE_REP >> (bit)) & 1))
__global__ void __launch_bounds__(512) mega(Params p) {
    extern __shared__ __attribute__((aligned(16))) unsigned char smem[];
    cg::grid_group grid = cg::this_grid();
    volatile LAS unsigned* xst = (volatile LAS unsigned*)((LAS unsigned char*)smem + LDS_BYTES - 16);
    if (threadIdx.x == 0) { xst[0] = 0u; xst[1] = 0u; }
    __syncthreads();
    const XcdBarrier xb = xcd_barrier_post((unsigned*)(p.ws + WS_BAR), xst);
    const float* MOD = (const float*)(p.ws + WS_MOD);
    bf16_t* H = (bf16_t*)(p.ws + WS_H); bf16_t* Zb = (bf16_t*)(p.ws + WS_Z); bf16_t* MRG = (bf16_t*)(p.ws + WS_MRG); bf16_t* HID = (bf16_t*)(p.ws + WS_UT);
    const bf16_t* WinT = (const bf16_t*)(p.ws + WS_WIN); const bf16_t* WoutT = (const bf16_t*)(p.ws + WS_WOUT); const bf16_t* W1T = (const bf16_t*)(p.ws + WS_W1); const bf16_t* W2T = (const bf16_t*)(p.ws + WS_W2);
    for (int ph = p.ph_lo; ph < p.ph_hi; ++ph) {
        if (ph == 0) { for (int rep = 0; rep < NREP(8); ++rep) { phase_modp(p, smem); phase_convert(p, 0, smem); } }
        else if (ph == 1) phase_modreduce(p);
        else if (ph == NPH - 1) phase_final(p.out, p.final_g, p.out);
        else {
            const int l = (ph - 2) / 10, s = (ph - 2) % 10; const float* mod = MOD + (size_t)l * 2 * NMOD;
            if (s == 0) { if (l == 1) phase_convert(p, 1, smem); for (int rep = 0; rep < NREP(7); ++rep) phase_norm(l == 0 ? p.x : p.out, p.norm1_g + l * DM, mod + 0, mod + 2048, H); }
            else if (s == 1) { for (int rep = 0; rep < NREP(0); ++rep) gemm_store(smem, H, WinT, NINP, DM, Zb, 0); }
            else if (s == 2) { for (int rep = 0; rep < NREP(2); ++rep) for (int u = BIDX(); u < 512; u += gridDim.x) gla1_unit(p, l, u, smem); for (int rep = 0; rep < NREP(3); ++rep) { phase_kvnorm(p, l); for (int u = BIDX(); u < 1056; u += gridDim.x) score_unit(p, u); } }
            else if (s == 3) { phase_gla_scan(p); for (int rep = 0; rep < NREP(4); ++rep) phase_topk(p); }
            else if (s == 4) { for (int rep = 0; rep < NREP(5); ++rep) for (int u = BIDX(); u < 512; u += gridDim.x) gla3_unit(p, l, u, smem); for (int rep = 0; rep < NREP(6); ++rep) { __syncthreads(); phase_attn(p, smem); } }
            else if (s == 5) { for (int u = BIDX(); u < 1024; u += gridDim.x) upproj_unit(p, u); }
            else if (s == 6) gemm_resid(smem, MRG, WoutT, DM, l == 0 ? p.x : p.out, p.out, mod + 4096);
            else if (s == 7) phase_norm(p.out, p.norm2_g + l * DM, mod + 6144, mod + 8192, H);
            else if (s == 8) { for (int rep = 0; rep < NREP(1); ++rep) gemm_store(smem, H, W1T, DFF, DM, HID, 1); }
            else gemm_resid(smem, HID, W2T, DFF, p.out, p.out, mod + 10240);
        }
        if (ph + 1 < p.ph_hi) { if (ph == 0) grid.sync(); else xcd_barrier(xb); }
    }
}

extern "C" void kernel_launch(void* const* d_in, const int* in_sizes, int n_in, void* d_out, int out_size, void* d_ws, size_t ws_size, hipStream_t stream) {
    static int grid = 0;
    if (grid == 0) {
        if (n_in != 17 || out_size != NT * DM || ws_size < WS_END + 16384) { fprintf(stderr, "kernel_launch: unexpected shapes (n_in %d out %d ws %zu need %zu)\n", n_in, out_size, ws_size, (size_t)WS_END); grid = -1; return; }
        if (hipFuncSetAttribute((const void*)mega, hipFuncAttributeMaxDynamicSharedMemorySize, LDS_BYTES) != hipSuccess) { fprintf(stderr, "kernel_launch: hipFuncSetAttribute failed\n"); grid = -1; return; }
        int dev = 0, cus = 0, per_cu = 0;
        hipGetDevice(&dev); hipDeviceGetAttribute(&cus, hipDeviceAttributeMultiprocessorCount, dev);
        hipOccupancyMaxActiveBlocksPerMultiprocessor(&per_cu, (const void*)mega, 512, LDS_BYTES);
        if (per_cu < 1) { fprintf(stderr, "kernel_launch: occupancy query says %d blocks per CU\n", per_cu); }
        (void)hipGetLastError();
        grid = cus > 0 ? cus : 256;
    }
    if (grid < 0) return;
    if (hipMemsetAsync((unsigned char*)d_ws + WS_BAR, 0, XCD_BAR_WORDS * 4, stream) != hipSuccess) { fprintf(stderr, "kernel_launch: memset failed\n"); return; }
    Params p{};
    const float** pp = (const float**)&p;
    for (int i = 0; i < 17; ++i) pp[i] = (const float*)d_in[i];
    p.out = (float*)d_out; p.ws = (unsigned char*)d_ws;
#if MK_SINGLE
    p.ph_lo = 0; p.ph_hi = NPH;
    void* args[] = {&p};
    hipError_t e = hipLaunchCooperativeKernel((const void*)mega, dim3(grid), dim3(512), args, LDS_BYTES, stream);
    if (e != hipSuccess) fprintf(stderr, "cooperative launch failed: %s (grid %d)\n", hipGetErrorString(e), grid);
#else
    for (int ph = 0; ph < NPH; ++ph) { p.ph_lo = ph; p.ph_hi = ph + 1; hipLaunchKernelGGL(mega, dim3(grid), dim3(512), LDS_BYTES, stream, p); }
#endif
}
```

```cpp
#include <hip/hip_runtime.h>
#include <hip/hip_cooperative_groups.h>
#include <cstdio>
#include <cstdint>
namespace cg = cooperative_groups;
#ifndef MK_SINGLE
#define MK_SINGLE 1
#endif
__device__ __forceinline__ int TIDX() { int t = threadIdx.x; asm volatile("" : "+v"(t)); return t; }
__device__ __forceinline__ int BIDX() { int t = blockIdx.x; asm volatile("" : "+s"(t)); return t; }
namespace pg8 {
#define PG8_LAS __attribute__((address_space(3)))
typedef unsigned short bf16_t;
typedef short bf16x8 __attribute__((ext_vector_type(8)));
typedef float f32x4 __attribute__((ext_vector_type(4)));
typedef unsigned u32x4 __attribute__((ext_vector_type(4)));
constexpr int BM = 256, BK = 64, HALF = 128, HTB = HALF * BK * 2  , STAGE_BYTES = 8 * HTB, NXCD = 8, WGM = 8;

__host__ __device__ __forceinline__ int lds_byte(int r, int c) { const int st = (r >> 4) * 2 + (c >> 5), rr = r & 15, cc = c & 31, ob = rr * 64 + cc * 2; return st * 1024 + (ob ^ (((ob >> 9) & 1) << 5)); }
__host__ __device__ __forceinline__ void stage_rc(int b, int& R, int& C) { const int st = b / 1024, sb = b % 1024, swz = sb ^ (((sb >> 9) & 1) << 5); R = (st >> 1) * 16 + swz / 64; C = (st & 1) * 32 + (swz % 64) / 2; }
__host__ __device__ __forceinline__ int perm32(int rho) { const int n = rho >> 4, i = rho & 15; return 8 * (i >> 2) + 4 * n + (i & 3); }

struct Unit { int pm, pn; };
struct Gemm { const bf16_t* A; const bf16_t* Bt; int M, N, K; };

struct StaticOrder {
    int nM, nN, nwg, G, c;
    __host__ __device__ void init(int M, int N, int G_, int c_) { nM = M / BM; nN = N / BM; nwg = nM * nN; G = G_; c = c_; }
    __host__ __device__ bool next(int i, Unit& u) const {
        const long L = (long)i * G + c; if (L >= nwg) return false;
        int wgid = (int)L; { const int q = nwg / NXCD, r = nwg % NXCD, xcd = wgid % NXCD, off = wgid / NXCD; wgid = (xcd < r ? xcd * (q + 1) : r * (q + 1) + (xcd - r) * q) + off; }
        const int nig = WGM * nN, gid = wgid / nig, fm = gid * WGM, gsz = (nM - fm) < WGM ? (nM - fm) : WGM;
        u.pm = fm + ((wgid % nig) % gsz); u.pn = (wgid % nig) / gsz; return true;
    }
    __device__ __forceinline__ void a_ready(const Unit&) const {}
    __device__ __forceinline__ void done(const Unit&) const {}
};

__device__ __forceinline__ unsigned cvt_pk_bf16(float lo, float hi) { unsigned r; asm volatile("v_cvt_pk_bf16_f32 %0, %1, %2" : "=v"(r) : "v"(lo), "v"(hi)); return r; }
template <class Epi, class Sched, bool ALIGN_EPI = false, bool SP2 = false>
__device__ __forceinline__ void gemm_phase(PG8_LAS unsigned char* lds, const Gemm g, const Sched& S, const Epi& E) {
    const int tid = TIDX(), wid = __builtin_amdgcn_readfirstlane(tid >> 6), lane = tid & 63, wr = wid >> 2, wc = wid & 3, fr = lane & 15, fq = lane >> 4;
    const int K = g.K, nt = K / BK;
    unsigned voffA[2], voffB[2];
#pragma unroll
    for (int i = 0; i < 2; ++i) { int R, C; stage_rc(tid * 16 + i * 8192, R, C); const int Rb = Epi::PERM ? ((R & ~31) + perm32(R & 31)) : R;
        voffA[i] = (unsigned)(R * K + C) * 2u; voffB[i] = (unsigned)(Rb * K + C) * 2u; }
    const size_t kstep = (size_t)(BK * 2);
    const size_t hstep = (size_t)HALF * K * 2;
    const size_t tstep = 2 * hstep;
    const unsigned ldsw = (unsigned)wid * 1024u;
    const int aoff = lds_byte(wr * 64 + fr, fq * 8), boff = lds_byte(wc * 32 + fr, fq * 8);
#define PG8_SA(b, h) (((b) * 2 + (h)) * HTB)
#define PG8_SB(b, h) ((4 + (b) * 2 + (h)) * HTB)
#define PG8_STAGE(bufoff, gbase, voff) do { _Pragma("unroll") for (int _i = 0; _i < 2; ++_i) \
        __builtin_amdgcn_global_load_lds((const unsigned*)((const char*)(gbase) + (voff)[_i]), (PG8_LAS unsigned*)(lds + (bufoff) + ldsw + _i * 8192), 16, 0, 0); } while (0)
#define PG8_LDA(dst, b, h) do { _Pragma("unroll") for (int m = 0; m < 4; ++m) _Pragma("unroll") for (int k = 0; k < 2; ++k) dst[m][k] = *(const PG8_LAS bf16x8*)(lds + PG8_SA(b, h) + aoff + m * 2048 + k * 1024); } while (0)
#define PG8_LDB(dst, b, h) do { _Pragma("unroll") for (int n = 0; n < 2; ++n) _Pragma("unroll") for (int k = 0; k < 2; ++k) dst[n][k] = *(const PG8_LAS bf16x8*)(lds + PG8_SB(b, h) + boff + n * 2048 + k * 1024); } while (0)
#define PG8_MMA(ai, bj, At, Bt) do { __builtin_amdgcn_s_setprio(1); _Pragma("unroll") for (int m = 0; m < 4; ++m) _Pragma("unroll") for (int n = 0; n < 2; ++n) _Pragma("unroll") for (int k = 0; k < 2; ++k) \
        acc[ai][bj][m][n] = __builtin_amdgcn_mfma_f32_16x16x32_bf16(Bt[n][k], At[m][k], acc[ai][bj][m][n], 0, 0, 0); __builtin_amdgcn_s_setprio(0); } while (0)
#define PG8_WAIT_V(n) asm volatile("s_waitcnt vmcnt(" #n ")" ::: "memory")
#define PG8_WAIT_L(n) asm volatile("s_waitcnt lgkmcnt(" #n ")" ::: "memory")
#define PG8_BAR __builtin_amdgcn_s_barrier()
#define PG8_SCHED __builtin_amdgcn_sched_barrier(0)
    Unit cur, nxt; int ui = 0;
    if (!S.next(0, cur)) return;
    f32x4 acc[2][2][4][2];
#pragma unroll
    for (int a = 0; a < 2; ++a)
#pragma unroll
        for (int b = 0; b < 2; ++b)
#pragma unroll
            for (int m = 0; m < 4; ++m)
#pragma unroll
                for (int n = 0; n < 2; ++n) acc[a][b][m][n] = (f32x4){0.f, 0.f, 0.f, 0.f};
    bf16x8 At[4][2], B0[2][2], B1[2][2];
    const char* cA = (const char*)g.A + (size_t)cur.pm * tstep; const char* cB = (const char*)g.Bt + (size_t)cur.pn * tstep;
    S.a_ready(cur);
    if constexpr (SP2) {
        PG8_STAGE(PG8_SB(0, 0), cB, voffB); PG8_STAGE(PG8_SB(0, 1), cB + hstep, voffB); PG8_STAGE(PG8_SA(0, 0), cA, voffA); PG8_STAGE(PG8_SA(0, 1), cA + hstep, voffA);
        if (wr == 1) PG8_BAR;
        PG8_WAIT_V(2); PG8_BAR;
        PG8_STAGE(PG8_SB(1, 0), cB + kstep, voffB); PG8_STAGE(PG8_SA(1, 0), cA + kstep, voffA); PG8_STAGE(PG8_SB(1, 1), cB + hstep + kstep, voffB);
        PG8_WAIT_V(6); PG8_BAR;
    } else {
        PG8_STAGE(PG8_SB(0, 0), cB, voffB); PG8_STAGE(PG8_SA(0, 0), cA, voffA); PG8_STAGE(PG8_SB(0, 1), cB + hstep, voffB); PG8_STAGE(PG8_SA(0, 1), cA + hstep, voffA);
        if (wr == 1) PG8_BAR;
        PG8_WAIT_V(4); PG8_BAR;
        PG8_STAGE(PG8_SB(1, 0), cB + kstep, voffB); PG8_STAGE(PG8_SA(1, 0), cA + kstep, voffA); PG8_STAGE(PG8_SB(1, 1), cB + hstep + kstep, voffB);
        PG8_WAIT_V(6); PG8_BAR;
    }
    for (;;) {
        const bool has_next = S.next(ui + 1, nxt);
        const char* nA = has_next ? (const char*)g.A + (size_t)nxt.pm * tstep : cA; const char* nB = has_next ? (const char*)g.Bt + (size_t)nxt.pn * tstep : cB;
        for (int t = 0; t < nt; t += 2) {
            const bool last = (t == nt - 2);
            const char* a1 = cA + (size_t)(t + 1) * kstep;
            const char* a2 = last ? nA : cA + (size_t)(t + 2) * kstep; const char* b2 = last ? nB : cB + (size_t)(t + 2) * kstep;
            const char* a3 = a2 + kstep; const char* b3 = b2 + kstep;
            if (last && has_next) S.a_ready(nxt);
            if constexpr (SP2) {
            PG8_LDB(B0, 0, 0); PG8_LDB(B1, 0, 1); PG8_SCHED; PG8_LDA(At, 0, 0); PG8_STAGE(PG8_SA(1, 1), a1 + hstep, voffA);
            PG8_WAIT_V(8); PG8_WAIT_L(0); PG8_BAR; PG8_MMA(0, 0, At, B0); PG8_MMA(0, 1, At, B1); PG8_BAR; PG8_SCHED;
            PG8_LDA(At, 0, 1); PG8_STAGE(PG8_SB(0, 0), b2, voffB); PG8_STAGE(PG8_SB(0, 1), b2 + hstep, voffB); PG8_STAGE(PG8_SA(0, 0), a2, voffA);
            PG8_WAIT_V(8); PG8_WAIT_L(0); PG8_BAR; PG8_MMA(1, 0, At, B0); PG8_MMA(1, 1, At, B1); PG8_BAR; PG8_SCHED;
            PG8_LDB(B0, 1, 0); PG8_LDB(B1, 1, 1); PG8_SCHED; PG8_LDA(At, 1, 0); PG8_STAGE(PG8_SA(0, 1), a2 + hstep, voffA);
            PG8_WAIT_V(8); PG8_WAIT_L(0); PG8_BAR; PG8_MMA(0, 0, At, B0); PG8_MMA(0, 1, At, B1); PG8_BAR; PG8_SCHED;
            PG8_LDA(At, 1, 1); PG8_STAGE(PG8_SB(1, 0), b3, voffB); PG8_STAGE(PG8_SB(1, 1), b3 + hstep, voffB); PG8_STAGE(PG8_SA(1, 0), a3, voffA);
            PG8_WAIT_V(8); PG8_WAIT_L(0); PG8_BAR; PG8_MMA(1, 0, At, B0); PG8_MMA(1, 1, At, B1); PG8_BAR; PG8_SCHED;
            } else {
            PG8_LDB(B0, 0, 0); PG8_SCHED; PG8_LDA(At, 0, 0); PG8_STAGE(PG8_SA(1, 1), a1 + hstep, voffA);
            PG8_WAIT_L(8); PG8_BAR; PG8_WAIT_L(0); PG8_MMA(0, 0, At, B0); PG8_BAR; PG8_SCHED;
            PG8_LDB(B1, 0, 1); PG8_STAGE(PG8_SB(0, 0), b2, voffB);
            PG8_BAR; PG8_WAIT_L(0); PG8_MMA(0, 1, At, B1); PG8_BAR;
            PG8_LDA(At, 0, 1); PG8_STAGE(PG8_SA(0, 0), a2, voffA);
            PG8_BAR; PG8_WAIT_L(0); PG8_MMA(1, 0, At, B0); PG8_BAR; PG8_SCHED;
            PG8_STAGE(PG8_SB(0, 1), b2 + hstep, voffB);
            PG8_WAIT_V(6); PG8_BAR; PG8_MMA(1, 1, At, B1); PG8_BAR;
            PG8_LDB(B0, 1, 0); PG8_SCHED; PG8_LDA(At, 1, 0); PG8_STAGE(PG8_SA(0, 1), a2 + hstep, voffA);
            PG8_WAIT_L(8); PG8_BAR; PG8_WAIT_L(0); PG8_MMA(0, 0, At, B0); PG8_BAR; PG8_SCHED;
            PG8_LDB(B1, 1, 1); PG8_STAGE(PG8_SB(1, 0), b3, voffB);
            PG8_BAR; PG8_WAIT_L(0); PG8_MMA(0, 1, At, B1); PG8_BAR;
            PG8_LDA(At, 1, 1); PG8_STAGE(PG8_SA(1, 0), a3, voffA);
            PG8_BAR; PG8_WAIT_L(0); PG8_MMA(1, 0, At, B0); PG8_BAR; PG8_SCHED;
            PG8_STAGE(PG8_SB(1, 1), b3 + hstep, voffB);
            PG8_WAIT_V(6); PG8_BAR; PG8_MMA(1, 1, At, B1); PG8_BAR;
            }
        }
        if constexpr (ALIGN_EPI) { if (wr == 0) PG8_BAR; }
        if constexpr (!Epi::AFTER_DRAIN) { E(acc, cur, wr, wc, fr, fq); S.done(cur); }
        if (!has_next) break;
#pragma unroll
        for (int a = 0; a < 2; ++a)
#pragma unroll
            for (int b = 0; b < 2; ++b)
#pragma unroll
                for (int m = 0; m < 4; ++m)
#pragma unroll
                    for (int n = 0; n < 2; ++n) acc[a][b][m][n] = (f32x4){0.f, 0.f, 0.f, 0.f};
        cur = nxt; cA = nA; cB = nB; ++ui;
        if constexpr (ALIGN_EPI) { if (wr == 1) PG8_BAR; }
    }
    PG8_WAIT_V(0);
    if constexpr (!ALIGN_EPI) { if (wr == 0) PG8_BAR; }
    PG8_BAR;
    if constexpr (Epi::AFTER_DRAIN) { E.fused(acc, cur, wr, wc, fr, fq, lds, wid, lane); S.done(cur); }
#undef PG8_SA
#undef PG8_SB
#undef PG8_STAGE
#undef PG8_LDA
#undef PG8_LDB
#undef PG8_MMA
#undef PG8_WAIT_V
#undef PG8_WAIT_L
#undef PG8_BAR
#undef PG8_SCHED
}
}

using pg8::bf16_t; using pg8::bf16x8; using pg8::f32x4; using pg8::u32x4;
typedef unsigned u32x2 __attribute__((ext_vector_type(2)));
typedef short s16x4 __attribute__((ext_vector_type(4)));
#define LAS __attribute__((address_space(3)))

constexpr int DM = 2048, SEQ = 4096, NT = 8192, NINP = 15872, NIN = 15712, DFF = 8192, NMOD = 12288;
constexpr int ZQ = 0, ZK = 1024, ZV = 2048, ZA = 4096, ZR = 4112, ZQL = 6160, ZKV = 10256, ZIQ = 10512, ZIK = 11536, ZIW = 11600, ZGG = 11616, ZGD = 13664;
constexpr float EPS = 1e-6f;
constexpr int LDS_BYTES = 147456;
constexpr int NPH = 23;

constexpr size_t WS_WIN = 0;
constexpr size_t WS_WOUT = WS_WIN + (size_t)NINP * DM * 2;
constexpr size_t WS_W1 = WS_WOUT + (size_t)DM * DM * 2;
constexpr size_t WS_W2 = WS_W1 + (size_t)DFF * DM * 2;
constexpr size_t WS_WUV = WS_W2 + (size_t)DFF * DM * 2;
constexpr size_t WS_MODP = WS_WUV + (size_t)16 * 128 * 256 * 2;
constexpr size_t WS_MOD = WS_MODP + (size_t)2 * 64 * 2 * NMOD * 4;
constexpr size_t WS_H = WS_MOD + (size_t)2 * 2 * NMOD * 4;
constexpr size_t WS_Z = WS_H + (size_t)NT * DM * 2;
constexpr size_t WS_QT = WS_Z + (size_t)NT * NINP * 2;
constexpr size_t WS_AM = WS_QT + (size_t)NT * 1024 * 2;
constexpr size_t WS_VT = WS_AM + (size_t)512 * 64 * 64 * 2;
constexpr size_t WS_DEC = WS_VT + (size_t)512 * 512 * 64 * 2;
constexpr size_t WS_UT = WS_DEC + (size_t)512 * 256 * 4;
constexpr size_t WS_KVN = WS_UT + (size_t)512 * 512 * 256 * 2;
constexpr size_t WS_SC = WS_KVN + (size_t)NT * 256 * 2;
constexpr size_t WS_IDX = WS_SC + (size_t)NT * 4096 * 4;
constexpr size_t WS_MRG = WS_IDX + (size_t)NT * 256 * 4;
constexpr size_t WS_BAR = WS_MRG + (size_t)NT * DM * 2;
constexpr size_t WS_END = WS_BAR;

struct Params {
    const float *x, *c, *w_mod, *b_mod, *norm1_g, *w_in, *w_gate_up, *b_gate, *gla_norm_g, *kv_norm_g, *w_uv, *w_out, *norm2_g, *w_ff1, *w_ff2, *rel_bias, *final_g;
    float* out; unsigned char* ws; int ph_lo, ph_hi;
};

__device__ __forceinline__ unsigned f2bf(float f) { unsigned u = __builtin_bit_cast(unsigned, f); return (u + 0x7fffu + ((u >> 16) & 1u)) >> 16; }
__device__ __forceinline__ unsigned pk2(float lo, float hi) { return f2bf(lo) | (f2bf(hi) << 16); }
__device__ __forceinline__ float bf2f(unsigned v) { return __builtin_bit_cast(float, v << 16); }
__device__ __forceinline__ float wave_sum(float v) {
#pragma unroll
    for (int o = 1; o < 64; o <<= 1) v += __shfl_xor(v, o);
    return v;
}
#define LDS_WAIT() asm volatile("s_waitcnt lgkmcnt(0)" ::: "memory")
__device__ __forceinline__ float sigmoidf_(float x) { return 1.f / (1.f + __expf(-x)); }
__device__ __forceinline__ float logsig(float x) { return fminf(x, 0.f) - log1pf(expf(-fabsf(x))); }

template <int ACT> struct EpiStoreBf16 {
    static constexpr bool PERM = true, AFTER_DRAIN = false;
    bf16_t* O; int ldc;
    __device__ __forceinline__ void operator()(const f32x4 (&acc)[2][2][4][2], const pg8::Unit& u, int wr, int wc, int fr, int fq) const {
        const int row0 = u.pm * 256 + wr * 64 + fr, col0 = u.pn * 256 + wc * 32 + 8 * fq;
#pragma unroll
        for (int ai = 0; ai < 2; ++ai)
#pragma unroll
            for (int m = 0; m < 4; ++m) { bf16_t* rowp = O + (size_t)(row0 + ai * 128 + m * 16) * ldc + col0;
#pragma unroll
                for (int bj = 0; bj < 2; ++bj) { f32x4 v0 = acc[ai][bj][m][0], v1 = acc[ai][bj][m][1];
                    if (ACT == 1) {
#pragma unroll
                        for (int e = 0; e < 4; ++e) { float a = fmaxf(v0[e], 0.f), b = fmaxf(v1[e], 0.f); v0[e] = a * a; v1[e] = b * b; } }
                    u32x4 w; w.x = pk2(v0[0], v0[1]); w.y = pk2(v0[2], v0[3]); w.z = pk2(v1[0], v1[1]); w.w = pk2(v1[2], v1[3]);
                    *(u32x4*)(rowp + bj * 128) = w; } }
    }
};
struct EpiResidual {
    static constexpr bool PERM = false, AFTER_DRAIN = false;
    const float* base; float* out; const float* gate;
    __device__ __forceinline__ void operator()(const f32x4 (&acc)[2][2][4][2], const pg8::Unit& u, int wr, int wc, int fr, int fq) const {
        const int col0 = u.pn * 256 + wc * 32 + 4 * fq; const float* gb = gate + (size_t)((u.pm * 256) >> 12) * NMOD;
#pragma unroll
        for (int ai = 0; ai < 2; ++ai)
#pragma unroll
            for (int m = 0; m < 4; ++m) { const size_t off = (size_t)(u.pm * 256 + ai * 128 + wr * 64 + m * 16 + fr) * DM;
#pragma unroll
                for (int bj = 0; bj < 2; ++bj)
#pragma unroll
                    for (int n = 0; n < 2; ++n) { const int c = col0 + bj * 128 + n * 16; const f32x4 gv = *(const f32x4*)(gb + c), bs = *(const f32x4*)(base + off + c);
                        *(f32x4*)(out + off + c) = bs + gv * acc[ai][bj][m][n]; } }
    }
};

__device__ __forceinline__ void transpose_item(const float* __restrict__ W, int K, int N, bf16_t* __restrict__ WT, float* scr, int item, int lane) {
    const int nblk = N / 32, kb = item / nblk, nb = item % nblk, k0 = 64 * kb, n0 = 32 * nb;
#pragma unroll 8
    for (int i = 0; i < 32; ++i) { const int kk = 2 * i + (lane >> 5); scr[kk * 33 + (lane & 31)] = W[(size_t)(k0 + kk) * N + n0 + (lane & 31)]; }
    LDS_WAIT();
    const int c = lane & 7;
#pragma unroll
    for (int j = 0; j < 4; ++j) { const int n = (lane >> 3) + 8 * j; const float* s = scr + (8 * c) * 33 + n;
        u32x4 o; o.x = pk2(s[0 * 33], s[1 * 33]); o.y = pk2(s[2 * 33], s[3 * 33]); o.z = pk2(s[4 * 33], s[5 * 33]); o.w = pk2(s[6 * 33], s[7 * 33]);
        *(u32x4*)(WT + (size_t)(n0 + n) * K + k0 + 8 * c) = o; }
    LDS_WAIT();
}
__device__ __forceinline__ void phase_convert(const Params& p, int l, unsigned char* smem) {
    const int tid = TIDX(), lane = tid & 63, wave = tid >> 6;
    float* scr = (float*)(smem + 16384 + wave * 8448);
    const int gw = BIDX() * 8 + wave, NGW = gridDim.x * 8;
    bf16_t* WinT = (bf16_t*)(p.ws + WS_WIN); bf16_t* WoutT = (bf16_t*)(p.ws + WS_WOUT); bf16_t* W1T = (bf16_t*)(p.ws + WS_W1); bf16_t* W2T = (bf16_t*)(p.ws + WS_W2); bf16_t* WuvT = (bf16_t*)(p.ws + WS_WUV);
    constexpr int I_IN = 32 * (NIN / 32), I_OUT = 32 * 64, I_1 = 32 * 256, I_2 = 128 * 64, I_UV = 16 * 16;
    constexpr int NITEMS = I_IN + I_OUT + I_1 + I_2 + I_UV;
    for (int it = gw; it < NITEMS; it += NGW) {
        int r = it;
        if (r < I_IN) { transpose_item(p.w_in + (size_t)l * DM * NIN, DM, NIN, WinT, scr, r, lane); continue; } r -= I_IN;
        if (r < I_OUT) { transpose_item(p.w_out + (size_t)l * DM * DM, DM, DM, WoutT, scr, r, lane); continue; } r -= I_OUT;
        if (r < I_1) { transpose_item(p.w_ff1 + (size_t)l * DM * DFF, DM, DFF, W1T, scr, r, lane); continue; } r -= I_1;
        if (r < I_2) { transpose_item(p.w_ff2 + (size_t)l * DFF * DM, DFF, DM, W2T, scr, r, lane); continue; } r -= I_2;
        { const int hh = r >> 4, ri = r & 15; transpose_item(p.w_uv + ((size_t)l * 16 + hh) * 256 * 128, 256, 128, WuvT + (size_t)hh * 128 * 256, scr, ri, lane); }
    }
    const int gt = BIDX() * 512 + tid, NGT = gridDim.x * 512;
    for (int i = gt; i < (NINP - NIN) * DM / 8; i += NGT) *(u32x4*)(WinT + (size_t)NIN * DM + (size_t)i * 8) = (u32x4){0u, 0u, 0u, 0u};
}
__device__ __forceinline__ void phase_modp(const Params& p, unsigned char* smem) {
    const int tid = TIDX(), lane = tid & 63, wave = tid >> 6;
    float* ca = (float*)smem;
    for (int i = tid; i < 2 * DM; i += 512) { const float v = p.c[i]; ca[i] = v / (1.f + expf(-v)); }
    __syncthreads();
    float* MODP = (float*)(p.ws + WS_MODP);
    const int gw = BIDX() * 8 + wave, NGW = gridDim.x * 8;
    for (int u = gw; u < 2 * 48 * 64; u += NGW) {
        const int l = u / (48 * 64), r = u % (48 * 64), cgp = r >> 6, kc = r & 63;
        const float* W = p.w_mod + (size_t)l * DM * NMOD + (size_t)(kc * 32) * NMOD + cgp * 256 + lane * 4;
        f32x4 a0 = {0.f, 0.f, 0.f, 0.f}, a1 = {0.f, 0.f, 0.f, 0.f};
#pragma unroll 8
        for (int rr = 0; rr < 32; ++rr) { const f32x4 w = *(const f32x4*)(W + (size_t)rr * NMOD); const float c0 = ca[kc * 32 + rr], c1 = ca[DM + kc * 32 + rr]; a0 += c0 * w; a1 += c1 * w; }
        float* o = MODP + ((size_t)(l * 64 + kc) * 2) * NMOD + cgp * 256 + lane * 4;
        *(f32x4*)o = a0; *(f32x4*)(o + NMOD) = a1;
    }
}
__device__ __forceinline__ void phase_modreduce(const Params& p) {
    const int gt = BIDX() * 512 + TIDX();
    const float* MODP = (const float*)(p.ws + WS_MODP); float* MOD = (float*)(p.ws + WS_MOD);
    for (int i = gt; i < 2 * 2 * NMOD; i += gridDim.x * 512) {
        const int l = i / (2 * NMOD), b = (i / NMOD) & 1, j = i % NMOD;
        float s = p.b_mod[l * NMOD + j];
        for (int kc = 0; kc < 64; ++kc) s += MODP[((size_t)(l * 64 + kc) * 2 + b) * NMOD + j];
        MOD[i] = s;
    }
}

__device__ __forceinline__ void phase_norm(const float* X, const float* g, const float* sh, const float* sc, bf16_t* H) {
    const int lane = TIDX() & 63, wave = TIDX() >> 6;
    const int NGW = gridDim.x * 8;
    for (int row = BIDX() * 8 + wave; row < NT; row += 2 * NGW) {
        const int row2 = row + NGW < NT ? row + NGW : row;
        f32x4 v[2][8]; float ss[2] = {0.f, 0.f};
#pragma unroll
        for (int q = 0; q < 2; ++q) { const float* xr = X + (size_t)(q ? row2 : row) * DM + lane * 4;
#pragma unroll
            for (int j = 0; j < 8; ++j) v[q][j] = *(const f32x4*)(xr + j * 256); }
#pragma unroll
        for (int q = 0; q < 2; ++q)
#pragma unroll
            for (int j = 0; j < 8; ++j) ss[q] += (v[q][j][0] * v[q][j][0] + v[q][j][1] * v[q][j][1]) + (v[q][j][2] * v[q][j][2] + v[q][j][3] * v[q][j][3]);
#pragma unroll
        for (int q = 0; q < 2; ++q) { const int rr = q ? row2 : row; const int b = rr >> 12; const float rstd = rsqrtf(wave_sum(ss[q]) * (1.f / DM) + EPS);
#pragma unroll
            for (int j = 0; j < 8; ++j) { const int c = j * 256 + lane * 4; const f32x4 gv = *(const f32x4*)(g + c), sv = *(const f32x4*)(sc + (size_t)b * NMOD + c), hv = *(const f32x4*)(sh + (size_t)b * NMOD + c);
                const f32x4 o = (v[q][j] * rstd * gv) * (1.f + sv) + hv; u32x2 w; w.x = pk2(o[0], o[1]); w.y = pk2(o[2], o[3]);
                *(u32x2*)(H + (size_t)rr * DM + c) = w; } }
    }
}
__device__ __forceinline__ void phase_final(const float* X, const float* g, float* out) {
    const int lane = TIDX() & 63, wave = TIDX() >> 6;
    for (int row = BIDX() * 8 + wave; row < NT; row += gridDim.x * 8) {
        const float* xr = X + (size_t)row * DM + lane * 4;
        f32x4 v[8]; float ss = 0.f;
#pragma unroll
        for (int j = 0; j < 8; ++j) { v[j] = *(const f32x4*)(xr + j * 256); ss += (v[j][0] * v[j][0] + v[j][1] * v[j][1]) + (v[j][2] * v[j][2] + v[j][3] * v[j][3]); }
        const float rstd = rsqrtf(wave_sum(ss) * (1.f / DM) + EPS);
#pragma unroll
        for (int j = 0; j < 8; ++j) { const int c = j * 256 + lane * 4; const f32x4 gv = *(const f32x4*)(g + c); *(f32x4*)(out + (size_t)row * DM + c) = v[j] * rstd * gv; }
    }
}
#include <cstdlib>
#include <vector>

#define XB_TMO      128
#define XB_XCNT(j)  (256  + 64 * (j))
#define XB_XSUB(j)  (1280 + 64 * (j))
#define XB_XGEN(j)  (2304 + 64 * (j))
#define XB_TOP      3328
#define XB_TOPGEN   3392
#define XCD_BAR_WORDS 3456
#define XB_SPIN_CAP (1u << 18)


__device__ __forceinline__ unsigned xb_ld(unsigned* p)              { return __hip_atomic_load(p, __ATOMIC_RELAXED, __HIP_MEMORY_SCOPE_AGENT); }
__device__ __forceinline__ unsigned xb_add(unsigned* p, unsigned v) { return __hip_atomic_fetch_add(p, v, __ATOMIC_RELAXED, __HIP_MEMORY_SCOPE_AGENT); }
__device__ __forceinline__ unsigned xb_xcc_id() { return (unsigned)__builtin_amdgcn_s_getreg((3 << 11) | 20) & 0xFu; }
#define XB_SPIN(cond, bar) do { unsigned _sp = 0; while (cond) { __builtin_amdgcn_s_sleep(1); \
    if ((++_sp & 255u) == 0u) { if (xb_ld(&(bar)[XB_TMO])) break; if (_sp > XB_SPIN_CAP) { atomicAdd(&(bar)[XB_TMO], 1u); break; } } } } while (0)

struct XcdBarrier {
    unsigned* bar; unsigned x;
    volatile LAS unsigned* st;
};

__device__ __forceinline__ XcdBarrier xcd_barrier_post(unsigned* bar, volatile LAS unsigned* st) {
    XcdBarrier b; b.bar = bar; b.x = xb_xcc_id(); b.st = st;
    if (threadIdx.x == 0) (void)xb_add(&bar[XB_XCNT(b.x)], 1u);
    return b;
}
__device__ __forceinline__ void xcd_barrier_complete(unsigned* bar, unsigned x, unsigned& nloc, unsigned& nx) {
    const unsigned G = gridDim.x * gridDim.y * gridDim.z;
    unsigned sum, cnt, mine, sp = 0u;
    for (;;) {
        sum = 0u; cnt = 0u; mine = 0u;
#pragma unroll
        for (unsigned j = 0; j < 16; ++j) { const unsigned c = xb_ld(&bar[XB_XCNT(j)]); sum += c; cnt += (c > 0u) ? 1u : 0u; mine = (j == x) ? c : mine; }
        if (sum == G) break;
        __builtin_amdgcn_s_sleep(1);
        if ((++sp & 255u) == 0u) { if (xb_ld(&bar[XB_TMO])) break; if (sp > XB_SPIN_CAP) { atomicAdd(&bar[XB_TMO], 1u); break; } }
    }
    nloc = mine > 0u ? mine : 1u; nx = cnt > 0u ? cnt : 1u;
}

__device__ __forceinline__ void xcd_barrier(const XcdBarrier& b) {
    asm volatile("s_waitcnt vmcnt(0)" ::: "memory");
    __syncthreads();
    if (threadIdx.x == 0) {
        unsigned* bar = b.bar;
        __builtin_amdgcn_s_waitcnt(0);
        unsigned nloc = b.st[0], nx = b.st[1];
        if (nloc == 0u) { xcd_barrier_complete(bar, b.x, nloc, nx); b.st[0] = nloc; b.st[1] = nx; }
        const unsigned old = xb_add(&bar[XB_XSUB(b.x)], 1u);
        const unsigned gen = old / nloc;
        if (old + 1u == (gen + 1u) * nloc) {
            __builtin_amdgcn_fence(__ATOMIC_RELEASE, "agent");
            asm volatile("s_waitcnt vmcnt(0)" ::: "memory");
            const unsigned og = xb_add(&bar[XB_TOP], 1u);
            const unsigned tg = og / nx;
            if (og + 1u == (tg + 1u) * nx) xb_add(&bar[XB_TOPGEN], 1u);
            else XB_SPIN(xb_ld(&bar[XB_TOPGEN]) == tg, bar);
            __builtin_amdgcn_fence(__ATOMIC_ACQUIRE, "agent");
            xb_add(&bar[XB_XGEN(b.x)], 1u);
            asm volatile("s_waitcnt vmcnt(0)" ::: "memory");
        } else {
            XB_SPIN(xb_ld(&bar[XB_XGEN(b.x)]) == gen, bar);
            __builtin_amdgcn_fence(__ATOMIC_ACQUIRE, "agent");
            asm volatile("s_waitcnt vmcnt(0)" ::: "memory");
        }
    }
    __syncthreads();
}

#define MFMA16(a, b, c) __builtin_amdgcn_mfma_f32_16x16x32_bf16((a), (b), (c), 0, 0, 0)
__device__ __forceinline__ float logsig_fast(float x) { return fminf(x, 0.f) - __logf(1.f + __expf(-fabsf(x))); }
__device__ __forceinline__ void gla1_unit(const Params& p, int l, int u, unsigned char* smem) {
    const int tid = TIDX(), lane = tid & 63, wave = tid >> 6, fr = lane & 15, fq = lane >> 4;
    const int b = u >> 8, c = (u >> 2) & 63, h = u & 3, t0 = b * SEQ + c * 64;
    const bf16_t* Z = (const bf16_t*)(p.ws + WS_Z);
    float* AL = (float*)smem;
    float* TOT = (float*)(smem + 4096);
    bf16_t* KST = (bf16_t*)(smem + 6144);
    bf16_t* QS = (bf16_t*)(smem + 43008);
    bf16_t* KI = (bf16_t*)(smem + 76800);
    bf16_t* VT = (bf16_t*)(smem + 43008);
    bf16_t* QT = (bf16_t*)(p.ws + WS_QT) + ((size_t)(b * 4 + h) * SEQ + c * 64) * 256; bf16_t* AM = (bf16_t*)(p.ws + WS_AM); bf16_t* VTG = (bf16_t*)(p.ws + WS_VT) + (size_t)u * 32768; float* DEC = (float*)(p.ws + WS_DEC); bf16_t* UT = (bf16_t*)(p.ws + WS_UT);
    for (int i = tid; i < 1024; i += 512) AL[i] = bf2f(Z[(size_t)(t0 + (i >> 4)) * NINP + ZA + (i & 15)]);
#pragma unroll
    for (int k = 0; k < 4; ++k) { const int i = tid + 512 * k, row = i >> 5, ch = i & 31; const bf16_t* zr = Z + (size_t)(t0 + row) * NINP + h * 256 + ch * 8;
        *(u32x4*)(QS + row * 264 + ch * 8) = *(const u32x4*)(zr + ZQ); *(u32x4*)(KI + row * 264 + ch * 8) = *(const u32x4*)(zr + ZK); }
    const int d = tid & 255, half = tid >> 8;
    float w[16];
#pragma unroll
    for (int r = 0; r < 16; ++r) w[r] = p.w_gate_up[((size_t)l * 16 + r) * 1024 + h * 256 + d];
    const float bias = p.b_gate[l * 1024 + h * 256 + d];
    __syncthreads();
    float g[32];
    {   float sum = 0.f;
#pragma unroll
        for (int pl = 0; pl < 32; ++pl) { const int pos = half * 32 + pl; float x = bias;
#pragma unroll
            for (int r = 0; r < 16; ++r) x += AL[pos * 16 + r] * w[r];
            g[pl] = logsig_fast(x) * (1.f / 16.f); sum += g[pl]; }
        TOT[half * 256 + d] = sum; }
    __syncthreads();
    {   const float blast = TOT[d] + TOT[256 + d], eb = __expf(blast); float run = half ? TOT[d] : 0.f;
#pragma unroll
        for (int p8 = 0; p8 < 4; ++p8) { unsigned ks[8];
#pragma unroll
            for (int e = 0; e < 8; ++e) { const int pl = p8 * 8 + e, pos = half * 32 + pl;
                run += g[pl];
                const float er = __expf(run), ier = __builtin_amdgcn_rcpf(er);
                const float qv = bf2f(QS[pos * 264 + d]), kv = bf2f(KI[pos * 264 + d]);
                QS[pos * 264 + d] = (bf16_t)f2bf(qv * 0.0625f * er);
                KI[pos * 264 + d] = (bf16_t)f2bf(kv * ier);
                ks[e] = f2bf(kv * (eb * ier)); }
            u32x4 o; o.x = ks[0] | (ks[1] << 16); o.y = ks[2] | (ks[3] << 16); o.z = ks[4] | (ks[5] << 16); o.w = ks[6] | (ks[7] << 16);
            *(u32x4*)(KST + d * 72 + half * 32 + p8 * 8) = o; }
        if (half == 0) DEC[u * 256 + d] = eb; }
    __syncthreads();
#pragma unroll
    for (int k = 0; k < 4; ++k) { const int i = tid + 512 * k, row = i >> 5, ch = i & 31; *(u32x4*)(QT + row * 256 + ch * 8) = *(const u32x4*)(QS + row * 264 + ch * 8); }
#pragma unroll
    for (int tt = 0; tt < 2; ++tt) { const int id = wave * 2 + tt, it = id >> 2, jt = id & 3; f32x4 acc = {0.f, 0.f, 0.f, 0.f};
        if (jt <= it) {
#pragma unroll
            for (int s = 0; s < 8; ++s) { const bf16x8 a = *(const bf16x8*)(QS + (it * 16 + fr) * 264 + 32 * s + 8 * fq), bb = *(const bf16x8*)(KI + (jt * 16 + fr) * 264 + 32 * s + 8 * fq);
                acc = MFMA16(a, bb, acc); } }
#pragma unroll
        for (int r = 0; r < 4; ++r) { const int i = it * 16 + 4 * fq + r, j = jt * 16 + fr; AM[(size_t)u * 4096 + i * 64 + j] = (bf16_t)f2bf(j <= i ? acc[r] : 0.f); } }
    __syncthreads();
    {   u32x4 vr[8];
#pragma unroll
        for (int it = 0; it < 8; ++it) vr[it] = *(const u32x4*)(Z + (size_t)(t0 + lane) * NINP + ZV + h * 512 + (wave * 8 + it) * 8);
#pragma unroll
        for (int it = 0; it < 8; ++it) { const int dv0 = (wave * 8 + it) * 8;
#pragma unroll
            for (int e = 0; e < 4; ++e) { VT[(dv0 + 2 * e) * 72 + lane] = (bf16_t)(vr[it][e] & 0xffffu); VT[(dv0 + 2 * e + 1) * 72 + lane] = (bf16_t)(vr[it][e] >> 16); } } }
    __syncthreads();
#pragma unroll
    for (int k = 0; k < 8; ++k) { const int i = tid + 512 * k, dv = i >> 3, pc = i & 7; *(u32x4*)(VTG + dv * 64 + pc * 8) = *(const u32x4*)(VT + dv * 72 + pc * 8); }
    {   bf16x8 bfr[4][2];
#pragma unroll
        for (int nt = 0; nt < 4; ++nt)
#pragma unroll
            for (int s = 0; s < 2; ++s) bfr[nt][s] = *(const bf16x8*)(VT + (wave * 64 + nt * 16 + fr) * 72 + 32 * s + 8 * fq);
#pragma unroll 4
        for (int mt = 0; mt < 16; ++mt) { const bf16x8 a0 = *(const bf16x8*)(KST + (mt * 16 + fr) * 72 + 8 * fq), a1 = *(const bf16x8*)(KST + (mt * 16 + fr) * 72 + 32 + 8 * fq);
#pragma unroll
            for (int nt = 0; nt < 4; ++nt) { f32x4 acc = {0.f, 0.f, 0.f, 0.f}; acc = MFMA16(a0, bfr[nt][0], acc); acc = MFMA16(a1, bfr[nt][1], acc);
                u32x2 o; o.x = pk2(acc[0], acc[1]); o.y = pk2(acc[2], acc[3]);
                *(u32x2*)(UT + (size_t)u * 131072 + (size_t)(wave * 64 + nt * 16 + fr) * 256 + mt * 16 + 4 * fq) = o; } } }
    __syncthreads();
}

__device__ __forceinline__ void phase_gla_scan(const Params& p) {
    bf16_t* UT = (bf16_t*)(p.ws + WS_UT); const float* DEC = (const float*)(p.ws + WS_DEC);
    for (int gid = BIDX() * 512 + TIDX(); gid < 131072; gid += gridDim.x * 512) {
        const int bh = gid >> 14, b = bh >> 2, h = bh & 3, e = (gid & 16383) * 8, d0 = e & 255;
        float s[8];
#pragma unroll
        for (int i = 0; i < 8; ++i) s[i] = 0.f;
        for (int c4 = 0; c4 < 64; c4 += 4) { u32x4 uu[4]; f32x4 da[4], db[4];
#pragma unroll
            for (int k = 0; k < 4; ++k) { const int u = (b * 64 + c4 + k) * 4 + h; uu[k] = *(const u32x4*)(UT + (size_t)u * 131072 + e); da[k] = *(const f32x4*)(DEC + u * 256 + d0); db[k] = *(const f32x4*)(DEC + u * 256 + d0 + 4); }
#pragma unroll
            for (int k = 0; k < 4; ++k) { const int u = (b * 64 + c4 + k) * 4 + h;
                u32x4 o; o.x = pk2(s[0], s[1]); o.y = pk2(s[2], s[3]); o.z = pk2(s[4], s[5]); o.w = pk2(s[6], s[7]);
                *(u32x4*)(UT + (size_t)u * 131072 + e) = o;
                s[0] = da[k][0] * s[0] + bf2f(uu[k][0] & 0xffffu); s[1] = da[k][1] * s[1] + bf2f(uu[k][0] >> 16);
                s[2] = da[k][2] * s[2] + bf2f(uu[k][1] & 0xffffu); s[3] = da[k][3] * s[3] + bf2f(uu[k][1] >> 16);
                s[4] = db[k][0] * s[4] + bf2f(uu[k][2] & 0xffffu); s[5] = db[k][1] * s[5] + bf2f(uu[k][2] >> 16);
                s[6] = db[k][2] * s[6] + bf2f(uu[k][3] & 0xffffu); s[7] = db[k][3] * s[7] + bf2f(uu[k][3] >> 16); } }
    }
}

__device__ __forceinline__ void gla3_unit(const Params& p, int l, int u, unsigned char* smem) {
    const int tid = TIDX(), lane = tid & 63, wave = tid >> 6, fr = lane & 15, fq = lane >> 4;
    const int b = u >> 8, c = (u >> 2) & 63, h = u & 3, t0 = b * SEQ + c * 64;
    const bf16_t* Z = (const bf16_t*)(p.ws + WS_Z);
    bf16_t* QS = (bf16_t*)smem;
    bf16_t* AS = (bf16_t*)(smem + 33792);
    float* RED = (float*)(smem + 43008);
    float* RSTD = (float*)(smem + 45056);
    const bf16_t* QT = (const bf16_t*)(p.ws + WS_QT) + ((size_t)(b * 4 + h) * SEQ + c * 64) * 256; const bf16_t* AM = (const bf16_t*)(p.ws + WS_AM) + (size_t)u * 4096;
    const bf16_t* VTG = (const bf16_t*)(p.ws + WS_VT) + (size_t)u * 32768; const bf16_t* ST = (const bf16_t*)(p.ws + WS_UT) + (size_t)u * 131072; bf16_t* MRG = (bf16_t*)(p.ws + WS_MRG);
#pragma unroll
    for (int k = 0; k < 4; ++k) { const int i = tid + 512 * k, row = i >> 5, ch = i & 31; *(u32x4*)(QS + row * 264 + ch * 8) = *(const u32x4*)(QT + row * 256 + ch * 8); }
    { const int row = tid >> 3, ch = tid & 7; *(u32x4*)(AS + row * 72 + ch * 8) = *(const u32x4*)(AM + row * 64 + ch * 8); }
    __syncthreads();
    const int dv0 = wave * 64;
    f32x4 acc[4][4];
#pragma unroll
    for (int mt = 0; mt < 4; ++mt)
#pragma unroll
        for (int nt = 0; nt < 4; ++nt) acc[mt][nt] = (f32x4){0.f, 0.f, 0.f, 0.f};
#pragma unroll
    for (int s = 0; s < 8; ++s) { bf16x8 a[4], bb[4];
#pragma unroll
        for (int mt = 0; mt < 4; ++mt) a[mt] = *(const bf16x8*)(QS + (mt * 16 + fr) * 264 + 32 * s + 8 * fq);
#pragma unroll
        for (int nt = 0; nt < 4; ++nt) bb[nt] = *(const bf16x8*)(ST + (size_t)(dv0 + nt * 16 + fr) * 256 + 32 * s + 8 * fq);
#pragma unroll
        for (int mt = 0; mt < 4; ++mt)
#pragma unroll
            for (int nt = 0; nt < 4; ++nt) acc[mt][nt] = MFMA16(a[mt], bb[nt], acc[mt][nt]); }
#pragma unroll
    for (int s = 0; s < 2; ++s) { bf16x8 a[4], bb[4];
#pragma unroll
        for (int mt = 0; mt < 4; ++mt) a[mt] = *(const bf16x8*)(AS + (mt * 16 + fr) * 72 + 32 * s + 8 * fq);
#pragma unroll
        for (int nt = 0; nt < 4; ++nt) bb[nt] = *(const bf16x8*)(VTG + (dv0 + nt * 16 + fr) * 64 + 32 * s + 8 * fq);
#pragma unroll
        for (int mt = 0; mt < 4; ++mt)
#pragma unroll
            for (int nt = 0; nt < 4; ++nt) acc[mt][nt] = MFMA16(a[mt], bb[nt], acc[mt][nt]); }
#pragma unroll
    for (int mt = 0; mt < 4; ++mt)
#pragma unroll
        for (int r = 0; r < 4; ++r) { float ss = 0.f;
#pragma unroll
            for (int nt = 0; nt < 4; ++nt) ss += acc[mt][nt][r] * acc[mt][nt][r];
            ss += __shfl_xor(ss, 1); ss += __shfl_xor(ss, 2); ss += __shfl_xor(ss, 4); ss += __shfl_xor(ss, 8);
            if (fr == 0) RED[wave * 64 + mt * 16 + 4 * fq + r] = ss; }
    __syncthreads();
    if (tid < 64) { float t = 0.f;
#pragma unroll
        for (int w8 = 0; w8 < 8; ++w8) t += RED[w8 * 64 + tid];
        RSTD[tid] = rsqrtf(t * (1.f / 512.f) + EPS); }
    __syncthreads();
    const float* gn = p.gla_norm_g + l * 512;
    bf16_t* OS = (bf16_t*)(smem + 46080);
#pragma unroll
    for (int mt = 0; mt < 4; ++mt)
#pragma unroll
        for (int r = 0; r < 4; ++r) { const int i = mt * 16 + 4 * fq + r; const float rs = RSTD[i];
#pragma unroll
            for (int nt = 0; nt < 4; ++nt) OS[i * 520 + dv0 + nt * 16 + fr] = (bf16_t)f2bf(acc[mt][nt][r] * rs); }
    __syncthreads();
#pragma unroll
    for (int k = 0; k < 8; ++k) { const int i = tid + 512 * k, row = i >> 6, col = (i & 63) * 8; const size_t t = (size_t)(t0 + row);
        const u32x4 ov = *(const u32x4*)(OS + row * 520 + col), rv = *(const u32x4*)(Z + t * NINP + ZR + h * 512 + col), gv = *(const u32x4*)(Z + t * NINP + ZGG + h * 512 + col);
        const f32x4 g0 = *(const f32x4*)(gn + col), g1 = *(const f32x4*)(gn + col + 4);
        u32x4 o;
#pragma unroll
        for (int e = 0; e < 4; ++e) { const float r0 = bf2f(rv[e] & 0xffffu), r1 = bf2f(rv[e] >> 16), q0 = bf2f(gv[e] & 0xffffu), q1 = bf2f(gv[e] >> 16);
            const float gg0 = e < 2 ? g0[2 * e] : g1[2 * e - 4], gg1 = e < 2 ? g0[2 * e + 1] : g1[2 * e - 3];
            const float y0 = bf2f(ov[e] & 0xffffu) * gg0 * (r0 * sigmoidf_(r0)) * sigmoidf_(q0), y1 = bf2f(ov[e] >> 16) * gg1 * (r1 * sigmoidf_(r1)) * sigmoidf_(q1);
            o[e] = pk2(y0, y1); }
        *(u32x4*)(MRG + t * DM + h * 512 + col) = o; }
    __syncthreads();
}

__device__ __forceinline__ void phase_kvnorm(const Params& p, int l) {
    const int lane = TIDX() & 63, wave = TIDX() >> 6;
    const bf16_t* Z = (const bf16_t*)(p.ws + WS_Z); bf16_t* KVN = (bf16_t*)(p.ws + WS_KVN);
    const f32x4 gv = *(const f32x4*)(p.kv_norm_g + l * 256 + lane * 4);
    for (int row = BIDX() * 8 + wave; row < NT; row += gridDim.x * 8) {
        const u32x2 raw = *(const u32x2*)(Z + (size_t)row * NINP + ZKV + lane * 4);
        const float v0 = bf2f(raw.x & 0xffffu), v1 = bf2f(raw.x >> 16), v2 = bf2f(raw.y & 0xffffu), v3 = bf2f(raw.y >> 16);
        const float rstd = rsqrtf(wave_sum((v0 * v0 + v1 * v1) + (v2 * v2 + v3 * v3)) * (1.f / 256.f) + EPS);
        u32x2 o; o.x = pk2(v0 * rstd * gv[0], v1 * rstd * gv[1]); o.y = pk2(v2 * rstd * gv[2], v3 * rstd * gv[3]);
        *(u32x2*)(KVN + (size_t)row * 256 + lane * 4) = o;
    }
}
__device__ __forceinline__ void phase_scores(const Params& p) {
    const int lane = TIDX() & 63, wave = TIDX() >> 6, fr = lane & 15, fq = lane >> 4;
    const bf16_t* Z = (const bf16_t*)(p.ws + WS_Z); float* SC = (float*)(p.ws + WS_SC);
    for (int u = BIDX(); u < 1056; u += gridDim.x) {
        const int b = u / 528, i = u % 528; int qt = 0; while ((qt + 1) * (qt + 2) / 2 <= i) ++qt; const int kt = i - qt * (qt + 1) / 2;
        const size_t tq = (size_t)b * SEQ + qt * 128 + wave * 16 + fr, tk0 = (size_t)b * SEQ + kt * 128;
        const bf16_t* zk = Z + (tk0 + fr) * NINP + ZIK + 8 * fq;
        f32x4 sc[8];
#pragma unroll
        for (int m = 0; m < 8; ++m) sc[m] = (f32x4){0.f, 0.f, 0.f, 0.f};
#pragma unroll 1
        for (int hf = 0; hf < 2; ++hf) {
            const bf16_t* zq = Z + tq * NINP + ZIQ + hf * 512 + 8 * fq;
            bf16x8 iq[8][2]; float wg[8];
#pragma unroll
            for (int hh = 0; hh < 8; ++hh) { iq[hh][0] = *(const bf16x8*)(zq + hh * 64); iq[hh][1] = *(const bf16x8*)(zq + hh * 64 + 32); }
            const u32x4 w0 = *(const u32x4*)(Z + tq * NINP + ZIW + hf * 8);
#pragma unroll
            for (int e = 0; e < 4; ++e) { wg[2 * e] = bf2f(w0[e] & 0xffffu) * (0.25f * 0.125f); wg[2 * e + 1] = bf2f(w0[e] >> 16) * (0.25f * 0.125f); }
            bf16x8 n0 = *(const bf16x8*)(zk), n1 = *(const bf16x8*)(zk + 32);
#pragma unroll
            for (int m = 0; m < 8; ++m) {
                const bf16x8 a0 = n0, a1 = n1;
                if (m < 7) { n0 = *(const bf16x8*)(zk + (size_t)(m + 1) * 16 * NINP); n1 = *(const bf16x8*)(zk + (size_t)(m + 1) * 16 * NINP + 32); }
#pragma unroll
                for (int hh = 0; hh < 8; ++hh) { f32x4 acc = {0.f, 0.f, 0.f, 0.f}; acc = MFMA16(a0, iq[hh][0], acc); acc = MFMA16(a1, iq[hh][1], acc);
#pragma unroll
                    for (int r = 0; r < 4; ++r) sc[m][r] += wg[hh] * __builtin_amdgcn_fmed3f(acc[r], 0.f, __builtin_inff()); }
            }
        }
#pragma unroll
        for (int m = 0; m < 8; ++m) *(f32x4*)(SC + tq * SEQ + kt * 128 + m * 16 + 4 * fq) = sc[m];
    }
}
__device__ __forceinline__ unsigned f2key(unsigned uu) { return (uu & 0x80000000u) ? ~uu : (uu | 0x80000000u); }
__device__ __forceinline__ void phase_topk(const Params& p, unsigned char* smem) {
    const int lane = TIDX() & 63, wave = TIDX() >> 6;
    const float* SC = (const float*)(p.ws + WS_SC); int* IDX = (int*)(p.ws + WS_IDX);
    unsigned* kl = (unsigned*)(smem + wave * 16384);
    const unsigned long long lt = (1ull << lane) - 1ull;
    for (int k = BIDX() * 8 + wave; k < 4096; k += gridDim.x * 8) {
        const int b = k >> 11, tb0 = k & 2047;
        for (int hf = 0; hf < 2; ++hf) {
            const int tb = hf ? 4095 - tb0 : tb0, t = b * SEQ + tb, nv = tb + 1; int* out = IDX + (size_t)t * 256;
            if (nv <= 256) { for (int q = lane; q < 256; q += 64) out[q] = q < nv ? q : -1; continue; }
            const float* row = SC + (size_t)t * SEQ; const int ng = (nv + 255) >> 8;
            LDS_WAIT();
#pragma unroll 4
            for (int g = 0; g < ng; ++g) { const int e0 = g * 256 + lane * 4; const u32x4 raw = *(const u32x4*)(row + e0); u32x4 kk;
                kk.x = e0 + 0 < nv ? f2key(raw.x) : 0u; kk.y = e0 + 1 < nv ? f2key(raw.y) : 0u; kk.z = e0 + 2 < nv ? f2key(raw.z) : 0u; kk.w = e0 + 3 < nv ? f2key(raw.w) : 0u;
                *(u32x4*)(kl + e0) = kk; }
            LDS_WAIT();
            unsigned thr = 0u;
#pragma unroll 1
            for (int bit = 31; bit >= 0; --bit) { const unsigned cand = thr | (1u << bit); int cnt = 0;
#pragma unroll 4
                for (int g = 0; g < ng; ++g) { const u32x4 kk = *(const u32x4*)(kl + g * 256 + lane * 4);
                    cnt += __popcll(__ballot(kk.x >= cand)) + __popcll(__ballot(kk.y >= cand)) + __popcll(__ballot(kk.z >= cand)) + __popcll(__ballot(kk.w >= cand)); }
                if (cnt >= 256) thr = cand; }
            int cgt = 0;
#pragma unroll 4
            for (int g = 0; g < ng; ++g) { const u32x4 kk = *(const u32x4*)(kl + g * 256 + lane * 4);
                cgt += __popcll(__ballot(kk.x > thr)) + __popcll(__ballot(kk.y > thr)) + __popcll(__ballot(kk.z > thr)) + __popcll(__ballot(kk.w > thr)); }
            const int need = 256 - cgt; int base = 0, eqb = 0;
#pragma unroll 1
            for (int g = 0; g < ng; ++g) { const u32x4 kk = *(const u32x4*)(kl + g * 256 + lane * 4);
#pragma unroll
                for (int i = 0; i < 4; ++i) { const unsigned kv = kk[i]; const bool gt = kv > thr, eq = kv == thr; const unsigned long long meq = __ballot(eq);
                    const bool sel = gt || (eq && (eqb + __popcll(meq & lt)) < need); const unsigned long long ms = __ballot(sel);
                    if (sel) out[base + __popcll(ms & lt)] = g * 256 + lane * 4 + i;
                    base += __popcll(ms); eqb += __popcll(meq); } }
        }
    }
}
__device__ __forceinline__ s16x4 tr_read(const unsigned char* pl) {
    typedef short v4i16_t __attribute__((ext_vector_type(4)));
    return __builtin_bit_cast(s16x4, __builtin_amdgcn_ds_read_tr16_b64_v4i16((LAS v4i16_t*)(pl)));
}
__device__ __forceinline__ int rel_bucket(int rel) {
    if (rel < 16) return rel;
    const int v = 16 + (int)(log2f((float)rel * 0.0625f) * (16.f / 3.f));
    return v < 31 ? v : 31;
}
__device__ __forceinline__ void phase_attn(const Params& p, int l, unsigned char* smem) {
    const int tid = TIDX(), lane = tid & 63, wave = tid >> 6, fr = lane & 15, fq = lane >> 4;
    const bf16_t* Z = (const bf16_t*)(p.ws + WS_Z); const bf16_t* KVN = (const bf16_t*)(p.ws + WS_KVN); const int* IDX = (const int*)(p.ws + WS_IDX); bf16_t* OLAT = (bf16_t*)(p.ws + WS_SC);
    float* BT = (float*)(smem + 135168);
    float* BM = (float*)(smem + 135168 + 2048);
    float* GM = (float*)(smem + 135168 + 2048 + 64);
    int* BK = (int*)(smem + 135168 + 2048 + 128);
    BT[tid] = p.rel_bias[tid];
    if (tid < 129) BK[tid] = rel_bucket(tid);
    { float gv = tid < 256 ? fabsf(p.kv_norm_g[l * 256 + tid]) : 0.f;
#pragma unroll
      for (int o = 1; o < 64; o <<= 1) gv = fmaxf(gv, __shfl_xor(gv, o));
      if (lane == 0) GM[wave] = gv; }
    __syncthreads();
    if (tid < 16) { float m = BT[tid]; for (int bb = 1; bb < 32; ++bb) m = fmaxf(m, BT[bb * 16 + tid]); BM[tid] = m; }
    __syncthreads();
    float gmax = GM[0];
#pragma unroll
    for (int w8 = 1; w8 < 8; ++w8) gmax = fmaxf(gmax, GM[w8]);
    gmax *= 1.02f;
    const float bmax = BM[fr];
    unsigned char* kvl = smem + wave * 16896;
    const int q4 = (lane & 15) >> 2, p4 = lane & 3;
    for (int t = BIDX() * 8 + wave; t < NT; t += gridDim.x * 8) {
        const int tb = t & (SEQ - 1), nsel = tb + 1 < 256 ? tb + 1 : 256, nch = (nsel + 31) >> 5; const size_t bbase = (size_t)(t - tb);
        bf16x8 qf[8];
#pragma unroll
        for (int s = 0; s < 8; ++s) qf[s] = *(const bf16x8*)(Z + (size_t)t * NINP + ZQL + fr * 256 + 32 * s + 8 * fq);
        int idxr[4];
#pragma unroll
        for (int k = 0; k < 4; ++k) idxr[k] = IDX[(size_t)t * 256 + k * 64 + lane];
        u32x4 pre[16];
#pragma unroll
        for (int r = 0; r < 16; ++r) { int ridx = __shfl(idxr[0], 2 * r + (lane >> 5)); ridx = ridx < 0 ? 0 : ridx; pre[r] = *(const u32x4*)(KVN + (bbase + ridx) * 256 + (lane & 31) * 8); }
        f32x4 O[16];
#pragma unroll
        for (int c = 0; c < 16; ++c) O[c] = (f32x4){0.f, 0.f, 0.f, 0.f};
        float qn = 0.f;
#pragma unroll
        for (int s = 0; s < 8; ++s)
#pragma unroll
            for (int e = 0; e < 8; ++e) { const float qv = bf2f((unsigned)(unsigned short)qf[s][e]); qn += qv * qv; }
        qn += __shfl_xor(qn, 16); qn += __shfl_xor(qn, 32);
        const float mh = sqrtf(qn) * gmax + bmax;
        float l_run = 0.f;
#pragma unroll 1
        for (int ch = 0; ch < nch; ++ch) {
            const int k2 = ch >> 1; const int cur = k2 == 0 ? idxr[0] : (k2 == 1 ? idxr[1] : (k2 == 2 ? idxr[2] : idxr[3]));
            const int myidx = __shfl(cur, (ch & 1) * 32 + (lane & 31));
            LDS_WAIT();
#pragma unroll
            for (int r = 0; r < 16; ++r) *(u32x4*)(kvl + (2 * r + (lane >> 5)) * 528 + (lane & 31) * 16) = pre[r];
            if (ch + 1 < nch) { const int k3 = (ch + 1) >> 1; const int nxt = k3 == 0 ? idxr[0] : (k3 == 1 ? idxr[1] : (k3 == 2 ? idxr[2] : idxr[3]));
#pragma unroll
                for (int r = 0; r < 16; ++r) { int ridx = __shfl(nxt, ((ch + 1) & 1) * 32 + 2 * r + (lane >> 5)); ridx = ridx < 0 ? 0 : ridx; pre[r] = *(const u32x4*)(KVN + (bbase + ridx) * 256 + (lane & 31) * 8); } }
            LDS_WAIT();
            f32x4 s0 = {0.f, 0.f, 0.f, 0.f}, s1 = {0.f, 0.f, 0.f, 0.f};
#pragma unroll
            for (int s = 0; s < 8; ++s) { const bf16x8 a0 = *(const bf16x8*)(kvl + fr * 528 + (4 * s + fq) * 16), a1 = *(const bf16x8*)(kvl + (16 + fr) * 528 + (4 * s + fq) * 16);
                s0 = MFMA16(a0, qf[s], s0); s1 = MFMA16(a1, qf[s], s1); }
            float ps = 0.f; float pp[8];
#pragma unroll
            for (int r = 0; r < 4; ++r) { const int i0 = __shfl(myidx, 4 * fq + r), i1 = __shfl(myidx, 16 + 4 * fq + r);
                const int r0 = tb - i0 < 128 ? tb - i0 : 128, r1 = tb - i1 < 128 ? tb - i1 : 128;
                pp[r] = i0 >= 0 ? __expf(s0[r] * 0.0625f + BT[BK[r0] * 16 + fr] - mh) : 0.f;
                pp[4 + r] = i1 >= 0 ? __expf(s1[r] * 0.0625f + BT[BK[r1] * 16 + fr] - mh) : 0.f;
                ps += pp[r] + pp[4 + r]; }
            l_run += ps;
            u32x4 pw; pw.x = pk2(pp[0], pp[1]); pw.y = pk2(pp[2], pp[3]); pw.z = pk2(pp[4], pp[5]); pw.w = pk2(pp[6], pp[7]);
            const bf16x8 pb = __builtin_bit_cast(bf16x8, pw);
#pragma unroll
            for (int c = 0; c < 16; ++c) {
                const s16x4 v0 = tr_read(kvl + (4 * fq + q4) * 528 + 32 * c + 8 * p4), v1 = tr_read(kvl + (16 + 4 * fq + q4) * 528 + 32 * c + 8 * p4);
                bf16x8 af; af[0] = v0[0]; af[1] = v0[1]; af[2] = v0[2]; af[3] = v0[3]; af[4] = v1[0]; af[5] = v1[1]; af[6] = v1[2]; af[7] = v1[3];
                O[c] = MFMA16(af, pb, O[c]);
                if ((c & 3) == 3) __builtin_amdgcn_sched_barrier(0); }
        }
        float lt = l_run; lt += __shfl_xor(lt, 16); lt += __shfl_xor(lt, 32);
        const float inv = 1.f / lt;
#pragma unroll
        for (int c = 0; c < 16; ++c) { u32x2 o; o.x = pk2(O[c][0] * inv, O[c][1] * inv); o.y = pk2(O[c][2] * inv, O[c][3] * inv);
            *(u32x2*)(OLAT + (size_t)t * 4096 + fr * 256 + 16 * c + 4 * fq) = o; }
    }
}
__device__ __forceinline__ void upproj_unit(const Params& p, int u) {
    const int lane = TIDX() & 63, wave = TIDX() >> 6, fr = lane & 15, fq = lane >> 4;
    const int tt = u >> 4, hh = u & 15;
    const bf16_t* Z = (const bf16_t*)(p.ws + WS_Z); const bf16_t* OLAT = (const bf16_t*)(p.ws + WS_SC); const bf16_t* WuvT = (const bf16_t*)(p.ws + WS_WUV) + (size_t)hh * 128 * 256; bf16_t* MRG = (bf16_t*)(p.ws + WS_MRG);
    const size_t t = (size_t)tt * 128 + wave * 16 + fr;
    bf16x8 of[8];
#pragma unroll
    for (int s = 0; s < 8; ++s) of[s] = *(const bf16x8*)(OLAT + t * 4096 + hh * 256 + 32 * s + 8 * fq);
    u32x2 gr[8], mr[8];
#pragma unroll
    for (int j = 0; j < 8; ++j) { const int col = hh * 128 + 16 * j + 4 * fq; gr[j] = *(const u32x2*)(Z + t * NINP + ZGD + col); mr[j] = *(const u32x2*)(MRG + t * DM + col); }
    f32x4 acc[8];
#pragma unroll
    for (int j = 0; j < 8; ++j) { acc[j] = (f32x4){0.f, 0.f, 0.f, 0.f};
#pragma unroll
        for (int s = 0; s < 8; ++s) { const bf16x8 wf = *(const bf16x8*)(WuvT + (size_t)(16 * j + fr) * 256 + 32 * s + 8 * fq); acc[j] = MFMA16(wf, of[s], acc[j]); } }
#pragma unroll
    for (int j = 0; j < 8; ++j) { const int col = hh * 128 + 16 * j + 4 * fq;
        const float o0 = bf2f(mr[j].x & 0xffffu) + sigmoidf_(bf2f(gr[j].x & 0xffffu)) * acc[j][0], o1 = bf2f(mr[j].x >> 16) + sigmoidf_(bf2f(gr[j].x >> 16)) * acc[j][1];
        const float o2 = bf2f(mr[j].y & 0xffffu) + sigmoidf_(bf2f(gr[j].y & 0xffffu)) * acc[j][2], o3 = bf2f(mr[j].y >> 16) + sigmoidf_(bf2f(gr[j].y >> 16)) * acc[j][3];
        u32x2 o; o.x = pk2(o0, o1); o.y = pk2(o2, o3); *(u32x2*)(MRG + t * DM + col) = o; }
}

__device__ __forceinline__ void gemm_store(unsigned char* smem, const bf16_t* A, const bf16_t* Bt, int N, int K, bf16_t* O, int act) {
    pg8::Gemm g; g.A = A; g.Bt = Bt; g.M = NT; g.N = N; g.K = K;
    pg8::StaticOrder S; S.init(NT, N, (int)gridDim.x, (int)BIDX());
    if (act) { EpiStoreBf16<1> E; E.O = O; E.ldc = N; pg8::gemm_phase<EpiStoreBf16<1>, pg8::StaticOrder, true, true>((PG8_LAS unsigned char*)smem, g, S, E); }
    else { EpiStoreBf16<0> E; E.O = O; E.ldc = N; pg8::gemm_phase<EpiStoreBf16<0>, pg8::StaticOrder, true, true>((PG8_LAS unsigned char*)smem, g, S, E); }
}
__device__ __forceinline__ void gemm_resid(unsigned char* smem, const bf16_t* A, const bf16_t* Bt, int K, const float* base, float* out, const float* gate) {
    pg8::Gemm g; g.A = A; g.Bt = Bt; g.M = NT; g.N = DM; g.K = K;
    pg8::StaticOrder S; S.init(NT, DM, (int)gridDim.x, (int)BIDX());
    EpiResidual E; E.base = base; E.out = out; E.gate = gate;
    pg8::gemm_phase<EpiResidual, pg8::StaticOrder, true, true>((PG8_LAS unsigned char*)smem, g, S, E);
}

#ifndef PROBE_REP
#define PROBE_REP 0
#endif
#define NREP(bit) (1 + ((PROBE_REP >> (bit)) & 1))
__global__ void __launch_bounds__(512) mega(Params p) {
    extern __shared__ __attribute__((aligned(16))) unsigned char smem[];
    cg::grid_group grid = cg::this_grid();
    volatile LAS unsigned* xst = (volatile LAS unsigned*)((LAS unsigned char*)smem + LDS_BYTES - 16);
    if (threadIdx.x == 0) { xst[0] = 0u; xst[1] = 0u; }
    __syncthreads();
    const XcdBarrier xb = xcd_barrier_post((unsigned*)(p.ws + WS_BAR), xst);
    const float* MOD = (const float*)(p.ws + WS_MOD);
    bf16_t* H = (bf16_t*)(p.ws + WS_H); bf16_t* Zb = (bf16_t*)(p.ws + WS_Z); bf16_t* MRG = (bf16_t*)(p.ws + WS_MRG); bf16_t* HID = (bf16_t*)(p.ws + WS_UT);
    const bf16_t* WinT = (const bf16_t*)(p.ws + WS_WIN); const bf16_t* WoutT = (const bf16_t*)(p.ws + WS_WOUT); const bf16_t* W1T = (const bf16_t*)(p.ws + WS_W1); const bf16_t* W2T = (const bf16_t*)(p.ws + WS_W2);
    for (int ph = p.ph_lo; ph < p.ph_hi; ++ph) {
        if (ph == 0) { for (int rep = 0; rep < NREP(8); ++rep) { phase_modp(p, smem); phase_convert(p, 0, smem); } }
        else if (ph == 1) phase_modreduce(p);
        else if (ph == NPH - 1) phase_final(p.out, p.final_g, p.out);
        else {
            const int l = (ph - 2) / 10, s = (ph - 2) % 10; const float* mod = MOD + (size_t)l * 2 * NMOD;
            if (s == 0) { if (l == 1) phase_convert(p, 1, smem); for (int rep = 0; rep < NREP(7); ++rep) phase_norm(l == 0 ? p.x : p.out, p.norm1_g + l * DM, mod + 0, mod + 2048, H); }
            else if (s == 1) { for (int rep = 0; rep < NREP(0); ++rep) gemm_store(smem, H, WinT, NINP, DM, Zb, 0); }
            else if (s == 2) { for (int rep = 0; rep < NREP(2); ++rep) for (int u = BIDX(); u < 512; u += gridDim.x) gla1_unit(p, l, u, smem); for (int rep = 0; rep < NREP(3); ++rep) { phase_kvnorm(p, l); phase_scores(p); } }
            else if (s == 3) { phase_gla_scan(p); for (int rep = 0; rep < NREP(4); ++rep) phase_topk(p, smem); }
            else if (s == 4) { for (int rep = 0; rep < NREP(5); ++rep) for (int u = BIDX(); u < 512; u += gridDim.x) gla3_unit(p, l, u, smem); for (int rep = 0; rep < NREP(6); ++rep) { __syncthreads(); phase_attn(p, l, smem); } }
            else if (s == 5) { for (int u = BIDX(); u < 1024; u += gridDim.x) upproj_unit(p, u); }
            else if (s == 6) gemm_resid(smem, MRG, WoutT, DM, l == 0 ? p.x : p.out, p.out, mod + 4096);
            else if (s == 7) phase_norm(p.out, p.norm2_g + l * DM, mod + 6144, mod + 8192, H);
            else if (s == 8) { for (int rep = 0; rep < NREP(1); ++rep) gemm_store(smem, H, W1T, DFF, DM, HID, 1); }
            else gemm_resid(smem, HID, W2T, DFF, p.out, p.out, mod + 10240);
        }
        if (ph + 1 < p.ph_hi) { if (ph == 0) grid.sync(); else xcd_barrier(xb); }
    }
}

extern "C" void kernel_launch(void* const* d_in, const int* in_sizes, int n_in, void* d_out, int out_size, void* d_ws, size_t ws_size, hipStream_t stream) {
    static int grid = 0;
    if (grid == 0) {
        if (n_in != 17 || out_size != NT * DM || ws_size < WS_END + 16384) { fprintf(stderr, "kernel_launch: unexpected shapes (n_in %d out %d ws %zu need %zu)\n", n_in, out_size, ws_size, (size_t)WS_END); grid = -1; return; }
        if (hipFuncSetAttribute((const void*)mega, hipFuncAttributeMaxDynamicSharedMemorySize, LDS_BYTES) != hipSuccess) { fprintf(stderr, "kernel_launch: hipFuncSetAttribute failed\n"); grid = -1; return; }
        int dev = 0, cus = 0, per_cu = 0;
        hipGetDevice(&dev); hipDeviceGetAttribute(&cus, hipDeviceAttributeMultiprocessorCount, dev);
        hipOccupancyMaxActiveBlocksPerMultiprocessor(&per_cu, (const void*)mega, 512, LDS_BYTES);
        if (per_cu < 1) { fprintf(stderr, "kernel_launch: occupancy query says %d blocks per CU\n", per_cu); }
        (void)hipGetLastError();
        grid = cus > 0 ? cus : 256;
    }
    if (grid < 0) return;
    if (hipMemsetAsync((unsigned char*)d_ws + WS_BAR, 0, XCD_BAR_WORDS * 4, stream) != hipSuccess) { fprintf(stderr, "kernel_launch: memset failed\n"); return; }
    Params p{};
    const float** pp = (const float**)&p;
    for (int i = 0; i < 17; ++i) pp[i] = (const float*)d_in[i];
    p.out = (float*)d_out; p.ws = (unsigned char*)d_ws;
#if MK_SINGLE
    p.ph_lo = 0; p.ph_hi = NPH;
    void* args[] = {&p};
    hipError_t e = hipLaunchCooperativeKernel((const void*)mega, dim3(grid), dim3(512), args, LDS_BYTES, stream);
    if (e != hipSuccess) fprintf(stderr, "cooperative launch failed: %s (grid %d)\n", hipGetErrorString(e), grid);
#else
    for (int ph = 0; ph < NPH; ++ph) { p.ph_lo = ph; p.ph_hi = ph + 1; hipLaunchKernelGGL(mega, dim3(grid), dim3(512), LDS_BYTES, stream, p); }
#endif
}
```
